# Optimizing an MI355X kernel written in HIP

```python
import jax, jax.numpy as jnp
from jax import lax
import numpy as np

D_MODEL = 2048
BATCH = 4
SEQ = 4096
DEPTH = 1

PLE_DIM = 256
CONV_WIDTH = D_MODEL // 2
CONV_K = 3
HG_DK = 128
HG_DV = 128
HG_HEADS = (D_MODEL // 2) // HG_DV
CHUNK = 32
D_FF = ((8 * D_MODEL // 3 + 127) // 128) * 128
LN_EPS = 1e-5
RMS_EPS = 1e-6
ALPHA = (2.0 * DEPTH) ** 0.25
BETA = (8.0 * DEPTH) ** -0.25
MIX_SIZES = (CONV_WIDTH,) * 3 + (HG_HEADS * HG_DK,) * 2 + (HG_HEADS * HG_DV,) * 2 + (D_MODEL,) * 2
MIX_COLS = sum(MIX_SIZES)

kernel_name = "hybrid_conv_hgrn2_macaron_deepnorm"


def _split_points():
    return [int(s) for s in np.cumsum(MIX_SIZES)[:-1]]


def layer_norm(x, g, b):
    xf = x.astype(jnp.float32)
    mu = xf.mean(-1, keepdims=True)
    var = jnp.square(xf - mu).mean(-1, keepdims=True)
    y = (xf - mu) * lax.rsqrt(var + LN_EPS) * g.astype(jnp.float32) + b.astype(jnp.float32)
    return y.astype(x.dtype)


def swiglu(x, w_in, w_out):
    a, u = jnp.split(x @ w_in, 2, axis=-1)
    return (jax.nn.silu(a) * u) @ w_out


def causal_dwconv(u, w):
    return lax.conv_general_dilated(
        u, w[:, None, :].astype(u.dtype), window_strides=(1,), padding=[(CONV_K - 1, 0)],
        dimension_numbers=("NWC", "WIO", "NWC"), feature_group_count=u.shape[-1])


def short_conv_mixer(b_gate, c_gate, h, w_conv):
    return b_gate * causal_dwconv(c_gate * h, w_conv)


def chunked_gla(q, k, v, logf):
    bsz, s, h, dk = q.shape
    dv = v.shape[-1]
    n = s // CHUNK

    def to_chunks(t):
        return t.reshape(bsz, n, CHUNK, h, t.shape[-1]).transpose(1, 0, 3, 2, 4)

    qc, kc, vc, gc = to_chunks(q), to_chunks(k), to_chunks(v), to_chunks(logf)
    causal = jnp.tril(jnp.ones((CHUNK, CHUNK), dtype=bool))[:, :, None]

    def step(state, inp):
        qb, kb, vb, gb = inp
        cum = jnp.cumsum(gb, axis=2)
        o_inter = jnp.einsum('bhck,bhkv->bhcv', qb * jnp.exp(cum), state)
        diff = cum[:, :, :, None, :] - cum[:, :, None, :, :]
        decay = jnp.exp(jnp.where(causal, diff, -jnp.inf))
        scores = jnp.einsum('bhtk,bhsk,bhtsk->bhts', qb, kb, decay)
        o_intra = jnp.einsum('bhts,bhsv->bhtv', scores, vb)
        last = cum[:, :, -1:, :]
        new_state = (jnp.exp(last[:, :, 0, :])[..., None] * state
                     + jnp.einsum('bhsk,bhsv->bhkv', kb * jnp.exp(last - cum), vb))
        return new_state, o_inter + o_intra

    s0 = jnp.zeros((bsz, h, dk, dv), jnp.float32)
    _, o = lax.scan(step, s0, (qc, kc, vc, gc))
    return o.transpose(1, 0, 3, 2, 4).reshape(bsz, s, h, dv)


def hgrn2_mixer(q_raw, f_raw, i_in, g_raw, lower_bound, norm_w):
    bsz, s, _ = q_raw.shape
    f32 = jnp.float32
    q = jax.nn.silu(q_raw.astype(f32)).reshape(bsz, s, HG_HEADS, HG_DK)
    lb = lower_bound.reshape(HG_HEADS, HG_DK)
    f = lb + (1.0 - lb) * jax.nn.sigmoid(f_raw.astype(f32)).reshape(bsz, s, HG_HEADS, HG_DK)
    k = 1.0 - f
    v = i_in.astype(f32).reshape(bsz, s, HG_HEADS, HG_DV)
    o = chunked_gla(q, k, v, jnp.log(f))
    o = o * lax.rsqrt(jnp.mean(jnp.square(o), -1, keepdims=True) + RMS_EPS) * norm_w.astype(f32)
    o = o * jax.nn.silu(g_raw.astype(f32).reshape(bsz, s, HG_HEADS, HG_DV))
    return o.reshape(bsz, s, HG_HEADS * HG_DV).astype(q_raw.dtype)


def setup_inputs(seed: int = 0) -> dict:
    key = jax.random.key(seed)
    ks = jax.random.split(key, 18)
    nrm = lambda k, shape, scale: jax.random.normal(k, shape, jnp.float32) * scale
    L = DEPTH
    return {
        "x": nrm(ks[0], (BATCH, SEQ, D_MODEL), 1.0),
        "p": nrm(ks[1], (L, BATCH, SEQ, PLE_DIM), 1.0),
        "ln_g": 1.0 + nrm(ks[2], (L, 4, D_MODEL), 0.02),
        "ln_b": nrm(ks[3], (L, 4, D_MODEL), 0.02),
        "ffn1_w_in": nrm(ks[4], (L, D_MODEL, 2 * D_FF), D_MODEL ** -0.5),
        "ffn1_w_out": nrm(ks[5], (L, D_FF, D_MODEL), BETA * D_FF ** -0.5),
        "mix_w_in": nrm(ks[6], (L, D_MODEL, MIX_COLS), D_MODEL ** -0.5),
        "conv_w": nrm(ks[7], (L, CONV_K, CONV_WIDTH), CONV_K ** -0.5),
        "hg_lower_bound": nrm(ks[8], (L + 1, HG_HEADS * HG_DK), 0.1),
        "hg_norm_w": 1.0 + nrm(ks[9], (L, HG_DV), 0.02),
        "branch_w_conv": nrm(ks[10], (L, CONV_WIDTH, D_MODEL), BETA * CONV_WIDTH ** -0.5),
        "branch_w_hgrn": nrm(ks[11], (L, HG_HEADS * HG_DV, D_MODEL), BETA * (HG_HEADS * HG_DV) ** -0.5),
        "mix_w_out": nrm(ks[12], (L, D_MODEL, D_MODEL), BETA * D_MODEL ** -0.5),
        "ffn2_w_in": nrm(ks[13], (L, D_MODEL, 2 * D_FF), D_MODEL ** -0.5),
        "ffn2_w_out": nrm(ks[14], (L, D_FF, D_MODEL), BETA * D_FF ** -0.5),
        "ple_w_gate": nrm(ks[15], (L, D_MODEL, D_MODEL), D_MODEL ** -0.5),
        "ple_w_proj": nrm(ks[16], (L, PLE_DIM, D_MODEL), BETA * PLE_DIM ** -0.5),
    }


def reference(x, p, ln_g, ln_b, ffn1_w_in, ffn1_w_out, mix_w_in, conv_w, hg_lower_bound,
              hg_norm_w, branch_w_conv, branch_w_hgrn, mix_w_out, ffn2_w_in, ffn2_w_out,
              ple_w_gate, ple_w_proj):
    lower_bounds = jnp.cumsum(jax.nn.softmax(hg_lower_bound.astype(jnp.float32), axis=0), axis=0)
    splits = _split_points()
    for i in range(DEPTH):
        x = layer_norm(ALPHA * x + 0.5 * swiglu(x, ffn1_w_in[i], ffn1_w_out[i]), ln_g[i, 0], ln_b[i, 0])
        z = x @ mix_w_in[i]
        b_gate, c_gate, h_conv, q_raw, f_raw, i_in, g_raw, gate_conv, gate_hgrn = jnp.split(z, splits, axis=-1)
        y_conv = short_conv_mixer(b_gate, c_gate, h_conv, conv_w[i])
        y_hgrn = hgrn2_mixer(q_raw, f_raw, i_in, g_raw, lower_bounds[i], hg_norm_w[i])
        merged = (jax.nn.sigmoid(gate_conv) * (y_conv @ branch_w_conv[i])
                  + jax.nn.sigmoid(gate_hgrn) * (y_hgrn @ branch_w_hgrn[i]))
        x = layer_norm(ALPHA * x + merged @ mix_w_out[i], ln_g[i, 1], ln_b[i, 1])
        x = layer_norm(ALPHA * x + 0.5 * swiglu(x, ffn2_w_in[i], ffn2_w_out[i]), ln_g[i, 2], ln_b[i, 2])
        ple = jax.nn.sigmoid(x @ ple_w_gate[i]) * (p[i] @ ple_w_proj[i])
        x = layer_norm(ALPHA * x + ple, ln_g[i, 3], ln_b[i, 3])
    return x
```

```cpp
#define MK_N_LAUNCHES 1
#define MK_WGM 4
#include <hip/hip_runtime.h>
#include <hip/hip_cooperative_groups.h>
#include <cstdio>
#include <cstdint>
namespace cg = cooperative_groups;
namespace pg8 {
#define PG8_LAS __attribute__((address_space(3)))
typedef unsigned short bf16_t;
typedef short bf16x8 __attribute__((ext_vector_type(8)));
typedef float f32x4 __attribute__((ext_vector_type(4)));
typedef unsigned u32x4 __attribute__((ext_vector_type(4)));
constexpr int BM = 256, BK = 64, HALF = 128, HTB = HALF * BK * 2  , STAGE_BYTES = 8 * HTB, NXCD = 8, WGM = MK_WGM;

__host__ __device__ __forceinline__ int lds_byte(int r, int c) { const int st = (r >> 4) * 2 + (c >> 5), rr = r & 15, cc = c & 31, ob = rr * 64 + cc * 2; return st * 1024 + (ob ^ (((ob >> 9) & 1) << 5)); }
__host__ __device__ __forceinline__ void stage_rc(int b, int& R, int& C) { const int st = b / 1024, sb = b % 1024, swz = sb ^ (((sb >> 9) & 1) << 5); R = (st >> 1) * 16 + swz / 64; C = (st & 1) * 32 + (swz % 64) / 2; }
__host__ __device__ __forceinline__ int perm32(int rho) { const int n = rho >> 4, i = rho & 15; return 8 * (i >> 2) + 4 * n + (i & 3); }

struct Unit { int pm, pn; };
struct Gemm { const bf16_t* A; const bf16_t* Bt; int M, N, K; int lda = 0, ldb = 0; };

struct StaticOrder {
    int nM, nN, nwg, G, c, wgm;
    __host__ __device__ void init(int M, int N, int G_, int c_, int wgm_ = WGM) { nM = M / BM; nN = N / BM; nwg = nM * nN; G = G_; c = c_; wgm = wgm_; }
    __host__ __device__ bool next(int i, Unit& u) const {
        const long L = (long)i * G + c; if (L >= nwg) return false;
        int wgid = (int)L; { const int q = nwg / NXCD, r = nwg % NXCD, xcd = wgid % NXCD, off = wgid / NXCD; wgid = (xcd < r ? xcd * (q + 1) : r * (q + 1) + (xcd - r) * q) + off; }
        const int nig = wgm * nN, gid = wgid / nig, fm = gid * wgm, gsz = (nM - fm) < wgm ? (nM - fm) : wgm;
        u.pm = fm + ((wgid % nig) % gsz); u.pn = (wgid % nig) / gsz; return true;
    }
    __device__ __forceinline__ void a_ready(const Unit&) const {}
    __device__ __forceinline__ void done(const Unit&) const {}
};
typedef __bf16 bf16v2_t __attribute__((ext_vector_type(2)));
typedef float f32x2 __attribute__((ext_vector_type(2)));
__device__ __forceinline__ unsigned cvt_pk_bf16(float lo, float hi) { const f32x2 v = {lo, hi}; const bf16v2_t r = __builtin_convertvector(v, bf16v2_t); return __builtin_bit_cast(unsigned, r); }
__device__ __forceinline__ float bf_lo(unsigned w) { return __uint_as_float(w << 16); }
__device__ __forceinline__ float bf_hi(unsigned w) { return __uint_as_float(w & 0xffff0000u); }
__device__ __forceinline__ float sigm(float x) { return __builtin_amdgcn_rcpf(1.0f + __builtin_amdgcn_exp2f(-1.4426950408889634f * x)); }
__device__ __forceinline__ u32x4 pack8(const f32x4 v0, const f32x4 v1) { u32x4 w; w.x = cvt_pk_bf16(v0[0], v0[1]); w.y = cvt_pk_bf16(v0[2], v0[3]); w.z = cvt_pk_bf16(v1[0], v1[1]); w.w = cvt_pk_bf16(v1[2], v1[3]); return w; }

struct EpiSwiGLU {
    static constexpr bool PERM = true, AFTER_DRAIN = false;
    bf16_t* H; int ldc;
    __device__ __forceinline__ void operator()(const f32x4 (&acc)[2][2][4][2], const Unit& u, int wr, int wc, int fr, int fq) const {
        const int row0 = u.pm * BM + wr * 64 + fr, col0 = u.pn * HALF + wc * 32 + 8 * fq;
#pragma unroll
        for (int ai = 0; ai < 2; ++ai)
#pragma unroll
            for (int m = 0; m < 4; ++m) { bf16_t* rowp = H + (size_t)(row0 + ai * HALF + m * 16) * ldc + col0;
                f32x4 h0, h1;
#pragma unroll
                for (int j = 0; j < 4; ++j) { const float a0 = acc[ai][0][m][0][j], a1 = acc[ai][0][m][1][j]; h0[j] = a0 * sigm(a0) * acc[ai][1][m][0][j]; h1[j] = a1 * sigm(a1) * acc[ai][1][m][1][j]; }
                *(u32x4*)rowp = pack8(h0, h1); }
    }
};
struct EpiResid {
    static constexpr bool PERM = true, AFTER_DRAIN = false;
    const float* res; float* out; float alpha, scale;
    __device__ __forceinline__ void operator()(const f32x4 (&acc)[2][2][4][2], const Unit& u, int wr, int wc, int fr, int fq) const {
        const int row0 = u.pm * BM + wr * 64 + fr, col0 = u.pn * BM + wc * 32 + 8 * fq;
#pragma unroll
        for (int ai = 0; ai < 2; ++ai)
#pragma unroll
            for (int m = 0; m < 4; ++m) { const size_t off = (size_t)(row0 + ai * HALF + m * 16) * 2048 + col0;
#pragma unroll
                for (int bj = 0; bj < 2; ++bj)
#pragma unroll
                    for (int n = 0; n < 2; ++n) { const f32x4 r = *(const f32x4*)(res + off + bj * HALF + 4 * n); *(f32x4*)(out + off + bj * HALF + 4 * n) = r * alpha + acc[ai][bj][m][n] * scale; }
                asm volatile("" ::: "memory"); }
    }
};
struct EpiMix {
    static constexpr bool PERM = true, AFTER_DRAIN = false;
    bf16_t* Z; size_t SZ;
    __device__ __forceinline__ void operator()(const f32x4 (&acc)[2][2][4][2], const Unit& u, int wr, int wc, int fr, int fq) const {
        const int pn = u.pn; int mode, ldc, cb; bf16_t* dst;
        if (pn < 4) { mode = 0; dst = Z; ldc = 1024; cb = 256 * pn; }
        else if (pn < 12) { mode = 1; dst = Z + SZ; ldc = 1024; cb = 128 * (pn - 4); }
        else if (pn < 28) { mode = 0; dst = Z + (size_t)(2 + ((pn - 12) >> 2)) * SZ; ldc = 1024; cb = 256 * ((pn - 12) & 3); }
        else { mode = 2; dst = Z + (size_t)(6 + 2 * ((pn - 28) >> 3)) * SZ; ldc = 2048; cb = 256 * ((pn - 28) & 7); }
        const int row0 = u.pm * BM + wr * 64 + fr, col0 = cb + wc * 32 + 8 * fq;
        if (mode == 1) {
#pragma unroll
            for (int ai = 0; ai < 2; ++ai)
#pragma unroll
                for (int m = 0; m < 4; ++m) { bf16_t* rowp = dst + (size_t)(row0 + ai * HALF + m * 16) * ldc + col0;
                    *(u32x4*)rowp = pack8(acc[ai][0][m][0] * acc[ai][1][m][0], acc[ai][0][m][1] * acc[ai][1][m][1]); }
        } else if (mode == 0) {
#pragma unroll
            for (int ai = 0; ai < 2; ++ai)
#pragma unroll
                for (int m = 0; m < 4; ++m) { bf16_t* rowp = dst + (size_t)(row0 + ai * HALF + m * 16) * ldc + col0;
#pragma unroll
                    for (int bj = 0; bj < 2; ++bj) *(u32x4*)(rowp + bj * HALF) = pack8(acc[ai][bj][m][0], acc[ai][bj][m][1]); }
        } else {
#pragma unroll
            for (int ai = 0; ai < 2; ++ai)
#pragma unroll
                for (int m = 0; m < 4; ++m) { bf16_t* rowp = dst + (size_t)(row0 + ai * HALF + m * 16) * ldc + col0;
#pragma unroll
                    for (int bj = 0; bj < 2; ++bj) { f32x4 s0, s1;
#pragma unroll
#ifdef MK_NOSIG
                        for (int j = 0; j < 4; ++j) { s0[j] = acc[ai][bj][m][0][j]; s1[j] = acc[ai][bj][m][1][j]; }
#else
                        for (int j = 0; j < 4; ++j) { s0[j] = sigm(acc[ai][bj][m][0][j]); s1[j] = sigm(acc[ai][bj][m][1][j]); }
#endif
                        *(u32x4*)(rowp + bj * HALF) = pack8(s0, s1); } }
        }
    }
};
struct EpiBr1 {
    static constexpr bool PERM = true, AFTER_DRAIN = false;
    const bf16_t* sg; bf16_t* T1;
    __device__ __forceinline__ void operator()(const f32x4 (&acc)[2][2][4][2], const Unit& u, int wr, int wc, int fr, int fq) const {
        const int row0 = u.pm * BM + wr * 64 + fr, col0 = u.pn * BM + wc * 32 + 8 * fq;
#pragma unroll
        for (int ai = 0; ai < 2; ++ai)
#pragma unroll
            for (int m = 0; m < 4; ++m) { const size_t off = (size_t)(row0 + ai * HALF + m * 16) * 2048 + col0;
#pragma unroll
                for (int bj = 0; bj < 2; ++bj) { const u32x4 s = *(const u32x4*)(sg + off + bj * HALF);
                    const f32x4 g0 = (f32x4){bf_lo(s.x), bf_hi(s.x), bf_lo(s.y), bf_hi(s.y)}, g1 = (f32x4){bf_lo(s.z), bf_hi(s.z), bf_lo(s.w), bf_hi(s.w)};
                    *(u32x4*)(T1 + off + bj * HALF) = pack8(g0 * acc[ai][bj][m][0], g1 * acc[ai][bj][m][1]); }
                asm volatile("" ::: "memory"); }
    }
};
struct EpiBr2 {
    static constexpr bool PERM = true, AFTER_DRAIN = false;
    const bf16_t* sg; const bf16_t* T1; bf16_t* MG;
    __device__ __forceinline__ void operator()(const f32x4 (&acc)[2][2][4][2], const Unit& u, int wr, int wc, int fr, int fq) const {
        const int row0 = u.pm * BM + wr * 64 + fr, col0 = u.pn * BM + wc * 32 + 8 * fq;
#pragma unroll
        for (int ai = 0; ai < 2; ++ai)
#pragma unroll
            for (int m = 0; m < 4; ++m) { const size_t off = (size_t)(row0 + ai * HALF + m * 16) * 2048 + col0;
#pragma unroll
                for (int bj = 0; bj < 2; ++bj) { const u32x4 s = *(const u32x4*)(sg + off + bj * HALF);
                    const u32x4 tt = *(const u32x4*)(T1 + off + bj * HALF);
                    const f32x4 t0 = (f32x4){bf_lo(tt.x), bf_hi(tt.x), bf_lo(tt.y), bf_hi(tt.y)}, t1 = (f32x4){bf_lo(tt.z), bf_hi(tt.z), bf_lo(tt.w), bf_hi(tt.w)};
                    const f32x4 g0 = (f32x4){bf_lo(s.x), bf_hi(s.x), bf_lo(s.y), bf_hi(s.y)}, g1 = (f32x4){bf_lo(s.z), bf_hi(s.z), bf_lo(s.w), bf_hi(s.w)};
                    *(u32x4*)(MG + off + bj * HALF) = pack8(t0 + g0 * acc[ai][bj][m][0], t1 + g1 * acc[ai][bj][m][1]); }
                asm volatile("" ::: "memory"); }
    }
};
struct EpiF32P {
    static constexpr bool PERM = true, AFTER_DRAIN = false;
    bf16_t* C;
    __device__ __forceinline__ void operator()(const f32x4 (&acc)[2][2][4][2], const Unit& u, int wr, int wc, int fr, int fq) const {
        const int row0 = u.pm * BM + wr * 64 + fr, col0 = u.pn * BM + wc * 32 + 8 * fq;
#pragma unroll
        for (int ai = 0; ai < 2; ++ai)
#pragma unroll
            for (int m = 0; m < 4; ++m) { bf16_t* rowp = C + (size_t)(row0 + ai * HALF + m * 16) * 2048 + col0;
#pragma unroll
                for (int bj = 0; bj < 2; ++bj) *(u32x4*)(rowp + bj * HALF) = pack8(acc[ai][bj][m][0], acc[ai][bj][m][1]); }
    }
};
struct EpiPle {
    static constexpr bool PERM = true, AFTER_DRAIN = false;
    const float* PP; float* out; float alpha;
    __device__ __forceinline__ void operator()(const f32x4 (&acc)[2][2][4][2], const Unit& u, int wr, int wc, int fr, int fq) const {
        const int row0 = u.pm * BM + wr * 64 + fr, col0 = u.pn * BM + wc * 32 + 8 * fq;
#pragma unroll
        for (int ai = 0; ai < 2; ++ai)
#pragma unroll
            for (int m = 0; m < 4; ++m) { const size_t off = (size_t)(row0 + ai * HALF + m * 16) * 2048 + col0;
#pragma unroll
                for (int bj = 0; bj < 2; ++bj)
#pragma unroll
                    for (int n = 0; n < 2; ++n) { const f32x4 r = *(const f32x4*)(out + off + bj * HALF + 4 * n), p = *(const f32x4*)(PP + off + bj * HALF + 4 * n); f32x4 s;
#pragma unroll
                        for (int j = 0; j < 4; ++j) s[j] = sigm(acc[ai][bj][m][n][j]);
                        *(f32x4*)(out + off + bj * HALF + 4 * n) = r * alpha + s * p; }
                asm volatile("" ::: "memory"); }
    }
};

struct EpiResidLN {
    static constexpr bool PERM = true, AFTER_DRAIN = false;
    float* out; const f32x2* mr; const float* g; const float* b; float alpha, scale;
    __device__ __forceinline__ void operator()(const f32x4 (&acc)[2][2][4][2], const Unit& u, int wr, int wc, int fr, int fq) const {
        const int row0 = u.pm * BM + wr * 64 + fr, col0 = u.pn * BM + wc * 32 + 8 * fq;
#pragma unroll
        for (int ai = 0; ai < 2; ++ai)
#pragma unroll
            for (int m = 0; m < 4; ++m) { const int row = row0 + ai * HALF + m * 16; const size_t off = (size_t)row * 2048 + col0; const f32x2 s = mr[row];
#pragma unroll
                for (int bj = 0; bj < 2; ++bj)
#pragma unroll
                    for (int n = 0; n < 2; ++n) { const int c = col0 + bj * HALF + 4 * n; const f32x4 v = *(const f32x4*)(out + off + bj * HALF + 4 * n), gg = *(const f32x4*)(g + c), bb = *(const f32x4*)(b + c);
                        const f32x4 r = (v - s.x) * s.y * gg + bb; *(f32x4*)(out + off + bj * HALF + 4 * n) = r * alpha + acc[ai][bj][m][n] * scale; }
                asm volatile("" ::: "memory"); }
    }
};
struct EpiPleLN {
    static constexpr bool PERM = true, AFTER_DRAIN = false;
    const bf16_t* PP; float* out; const f32x2* mr; const float* g; const float* b; float alpha;
    __device__ __forceinline__ void operator()(const f32x4 (&acc)[2][2][4][2], const Unit& u, int wr, int wc, int fr, int fq) const {
        const int row0 = u.pm * BM + wr * 64 + fr, col0 = u.pn * BM + wc * 32 + 8 * fq;
#pragma unroll
        for (int ai = 0; ai < 2; ++ai)
#pragma unroll
            for (int m = 0; m < 4; ++m) { const int row = row0 + ai * HALF + m * 16; const size_t off = (size_t)row * 2048 + col0; const f32x2 s = mr[row];
#pragma unroll
                for (int bj = 0; bj < 2; ++bj) { const u32x4 pq = *(const u32x4*)(PP + off + bj * HALF);
#pragma unroll
                    for (int n = 0; n < 2; ++n) { const int c = col0 + bj * HALF + 4 * n; const f32x4 v = *(const f32x4*)(out + off + bj * HALF + 4 * n), p = n ? (f32x4){bf_lo(pq.z), bf_hi(pq.z), bf_lo(pq.w), bf_hi(pq.w)} : (f32x4){bf_lo(pq.x), bf_hi(pq.x), bf_lo(pq.y), bf_hi(pq.y)}, gg = *(const f32x4*)(g + c), bb = *(const f32x4*)(b + c); f32x4 sg;
#pragma unroll
                        for (int j = 0; j < 4; ++j) sg[j] = sigm(acc[ai][bj][m][n][j]);
                        const f32x4 r = (v - s.x) * s.y * gg + bb; *(f32x4*)(out + off + bj * HALF + 4 * n) = r * alpha + sg * p; } }
                asm volatile("" ::: "memory"); }
    }
};
template <class Epi, class Sched, bool ALIGN_EPI = false, bool SP2 = false>
__device__ __forceinline__ void gemm_phase(PG8_LAS unsigned char* lds, const Gemm g, const Sched& S, const Epi& E) {
    const int tid = threadIdx.x, wid = __builtin_amdgcn_readfirstlane(tid >> 6), lane = tid & 63, wr = wid >> 2, wc = wid & 3, fr = lane & 15, fq = lane >> 4;
    const int K = g.K, nt = K / BK, lda = g.lda ? g.lda : K, ldb = g.ldb ? g.ldb : K;
    unsigned voffA[2], voffB[2];
#pragma unroll
    for (int i = 0; i < 2; ++i) { int R, C; stage_rc(tid * 16 + i * 8192, R, C); const int Rb = Epi::PERM ? ((R & ~31) + perm32(R & 31)) : R;
        voffA[i] = (unsigned)(R * lda + C) * 2u; voffB[i] = (unsigned)(Rb * ldb + C) * 2u; }
    const size_t kstep = (size_t)(BK * 2);
    const size_t hstepA = (size_t)HALF * lda * 2, hstepB = (size_t)HALF * ldb * 2;
    const size_t tstepA = 2 * hstepA, tstepB = 2 * hstepB;
    const unsigned ldsw = (unsigned)wid * 1024u;
    const int aoff = lds_byte(wr * 64 + fr, fq * 8), boff = lds_byte(wc * 32 + fr, fq * 8);
#define PG8_SA(b, h) (((b) * 2 + (h)) * HTB)
#define PG8_SB(b, h) ((4 + (b) * 2 + (h)) * HTB)
#define PG8_STAGE(bufoff, gbase, voff) do { _Pragma("unroll") for (int _i = 0; _i < 2; ++_i) \
        __builtin_amdgcn_global_load_lds((const unsigned*)((const char*)(gbase) + (voff)[_i]), (PG8_LAS unsigned*)(lds + (bufoff) + ldsw + _i * 8192), 16, 0, 0); } while (0)
#define PG8_LDA(dst, b, h) do { _Pragma("unroll") for (int m = 0; m < 4; ++m) _Pragma("unroll") for (int k = 0; k < 2; ++k) dst[m][k] = *(const PG8_LAS bf16x8*)(lds + PG8_SA(b, h) + aoff + m * 2048 + k * 1024); } while (0)
#define PG8_LDB(dst, b, h) do { _Pragma("unroll") for (int n = 0; n < 2; ++n) _Pragma("unroll") for (int k = 0; k < 2; ++k) dst[n][k] = *(const PG8_LAS bf16x8*)(lds + PG8_SB(b, h) + boff + n * 2048 + k * 1024); } while (0)
#define PG8_MMA(ai, bj, At, Bt) do { __builtin_amdgcn_s_setprio(1); _Pragma("unroll") for (int m = 0; m < 4; ++m) _Pragma("unroll") for (int n = 0; n < 2; ++n) _Pragma("unroll") for (int k = 0; k < 2; ++k) \
        acc[ai][bj][m][n] = __builtin_amdgcn_mfma_f32_16x16x32_bf16(Bt[n][k], At[m][k], acc[ai][bj][m][n], 0, 0, 0); __builtin_amdgcn_s_setprio(0); } while (0)
#define PG8_WAIT_V(n) asm volatile("s_waitcnt vmcnt(" #n ")" ::: "memory")
#define PG8_WAIT_L(n) asm volatile("s_waitcnt lgkmcnt(" #n ")" ::: "memory")
#define PG8_BAR __builtin_amdgcn_s_barrier()
#define PG8_SCHED __builtin_amdgcn_sched_barrier(0)
    Unit cur, nxt; int ui = 0;
    if (!S.next(0, cur)) return;
    f32x4 acc[2][2][4][2];
#pragma unroll
    for (int a = 0; a < 2; ++a)
#pragma unroll
        for (int b = 0; b < 2; ++b)
#pragma unroll
            for (int m = 0; m < 4; ++m)
#pragma unroll
                for (int n = 0; n < 2; ++n) acc[a][b][m][n] = (f32x4){0.f, 0.f, 0.f, 0.f};
    bf16x8 At[4][2], B0[2][2], B1[2][2];
    const char* cA = (const char*)g.A + (size_t)cur.pm * tstepA; const char* cB = (const char*)g.Bt + (size_t)cur.pn * tstepB;
    S.a_ready(cur);
    if constexpr (SP2) {
        PG8_STAGE(PG8_SB(0, 0), cB, voffB); PG8_STAGE(PG8_SB(0, 1), cB + hstepB, voffB); PG8_STAGE(PG8_SA(0, 0), cA, voffA); PG8_STAGE(PG8_SA(0, 1), cA + hstepA, voffA);
        if (wr == 1) PG8_BAR;
        PG8_WAIT_V(2); PG8_BAR;
        PG8_STAGE(PG8_SB(1, 0), cB + kstep, voffB); PG8_STAGE(PG8_SA(1, 0), cA + kstep, voffA); PG8_STAGE(PG8_SB(1, 1), cB + hstepB + kstep, voffB);
        PG8_WAIT_V(6); PG8_BAR;
    } else {
        PG8_STAGE(PG8_SB(0, 0), cB, voffB); PG8_STAGE(PG8_SA(0, 0), cA, voffA); PG8_STAGE(PG8_SB(0, 1), cB + hstepB, voffB); PG8_STAGE(PG8_SA(0, 1), cA + hstepA, voffA);
        if (wr == 1) PG8_BAR;
        PG8_WAIT_V(4); PG8_BAR;
        PG8_STAGE(PG8_SB(1, 0), cB + kstep, voffB); PG8_STAGE(PG8_SA(1, 0), cA + kstep, voffA); PG8_STAGE(PG8_SB(1, 1), cB + hstepB + kstep, voffB);
        PG8_WAIT_V(6); PG8_BAR;
    }
    for (;;) {
        const bool has_next = S.next(ui + 1, nxt);
        const char* nA = has_next ? (const char*)g.A + (size_t)nxt.pm * tstepA : cA; const char* nB = has_next ? (const char*)g.Bt + (size_t)nxt.pn * tstepB : cB;
        for (int t = 0; t < nt; t += 2) {
            const bool last = (t == nt - 2);
            const char* a1 = cA + (size_t)(t + 1) * kstep;
            const char* a2 = last ? nA : cA + (size_t)(t + 2) * kstep; const char* b2 = last ? nB : cB + (size_t)(t + 2) * kstep;
            const char* a3 = a2 + kstep; const char* b3 = b2 + kstep;
            if (last && has_next) S.a_ready(nxt);
            if constexpr (SP2) {
            PG8_LDB(B0, 0, 0); PG8_LDB(B1, 0, 1); PG8_SCHED; PG8_LDA(At, 0, 0); PG8_STAGE(PG8_SA(1, 1), a1 + hstepA, voffA);
            PG8_WAIT_V(8); PG8_WAIT_L(0); PG8_BAR; PG8_MMA(0, 0, At, B0); PG8_MMA(0, 1, At, B1); PG8_BAR; PG8_SCHED;
            PG8_LDA(At, 0, 1); PG8_STAGE(PG8_SB(0, 0), b2, voffB); PG8_STAGE(PG8_SB(0, 1), b2 + hstepB, voffB); PG8_STAGE(PG8_SA(0, 0), a2, voffA);
            PG8_WAIT_V(8); PG8_WAIT_L(0); PG8_BAR; PG8_MMA(1, 0, At, B0); PG8_MMA(1, 1, At, B1); PG8_BAR; PG8_SCHED;
            PG8_LDB(B0, 1, 0); PG8_LDB(B1, 1, 1); PG8_SCHED; PG8_LDA(At, 1, 0); PG8_STAGE(PG8_SA(0, 1), a2 + hstepA, voffA);
            PG8_WAIT_V(8); PG8_WAIT_L(0); PG8_BAR; PG8_MMA(0, 0, At, B0); PG8_MMA(0, 1, At, B1); PG8_BAR; PG8_SCHED;
            PG8_LDA(At, 1, 1); PG8_STAGE(PG8_SB(1, 0), b3, voffB); PG8_STAGE(PG8_SB(1, 1), b3 + hstepB, voffB); PG8_STAGE(PG8_SA(1, 0), a3, voffA);
            PG8_WAIT_V(8); PG8_WAIT_L(0); PG8_BAR; PG8_MMA(1, 0, At, B0); PG8_MMA(1, 1, At, B1); PG8_BAR; PG8_SCHED;
            } else {
            PG8_LDB(B0, 0, 0); PG8_SCHED; PG8_LDA(At, 0, 0); PG8_STAGE(PG8_SA(1, 1), a1 + hstepA, voffA);
            PG8_WAIT_L(8); PG8_BAR; PG8_WAIT_L(0); PG8_MMA(0, 0, At, B0); PG8_BAR; PG8_SCHED;
            PG8_LDB(B1, 0, 1); PG8_STAGE(PG8_SB(0, 0), b2, voffB);
            PG8_BAR; PG8_WAIT_L(0); PG8_MMA(0, 1, At, B1); PG8_BAR;
            PG8_LDA(At, 0, 1); PG8_STAGE(PG8_SA(0, 0), a2, voffA);
            PG8_BAR; PG8_WAIT_L(0); PG8_MMA(1, 0, At, B0); PG8_BAR; PG8_SCHED;
            PG8_STAGE(PG8_SB(0, 1), b2 + hstepB, voffB);
            PG8_WAIT_V(6); PG8_BAR; PG8_MMA(1, 1, At, B1); PG8_BAR;
            PG8_LDB(B0, 1, 0); PG8_SCHED; PG8_LDA(At, 1, 0); PG8_STAGE(PG8_SA(0, 1), a2 + hstepA, voffA);
            PG8_WAIT_L(8); PG8_BAR; PG8_WAIT_L(0); PG8_MMA(0, 0, At, B0); PG8_BAR; PG8_SCHED;
            PG8_LDB(B1, 1, 1); PG8_STAGE(PG8_SB(1, 0), b3, voffB);
            PG8_BAR; PG8_WAIT_L(0); PG8_MMA(0, 1, At, B1); PG8_BAR;
            PG8_LDA(At, 1, 1); PG8_STAGE(PG8_SA(1, 0), a3, voffA);
            PG8_BAR; PG8_WAIT_L(0); PG8_MMA(1, 0, At, B0); PG8_BAR; PG8_SCHED;
            PG8_STAGE(PG8_SB(1, 1), b3 + hstepB, voffB);
            PG8_WAIT_V(6); PG8_BAR; PG8_MMA(1, 1, At, B1); PG8_BAR;
            }
        }
        if constexpr (ALIGN_EPI) { if (wr == 0) PG8_BAR; }
        if constexpr (!Epi::AFTER_DRAIN) { E(acc, cur, wr, wc, fr, fq); S.done(cur); }
        if (!has_next) break;
#pragma unroll
        for (int a = 0; a < 2; ++a)
#pragma unroll
            for (int b = 0; b < 2; ++b)
#pragma unroll
                for (int m = 0; m < 4; ++m)
#pragma unroll
                    for (int n = 0; n < 2; ++n) acc[a][b][m][n] = (f32x4){0.f, 0.f, 0.f, 0.f};
        cur = nxt; cA = nA; cB = nB; ++ui;
        if constexpr (ALIGN_EPI) { if (wr == 1) PG8_BAR; }
    }
    PG8_WAIT_V(0);
    if constexpr (!ALIGN_EPI) { if (wr == 0) PG8_BAR; }
    PG8_BAR;
    if constexpr (Epi::AFTER_DRAIN) { E.fused(acc, cur, wr, wc, fr, fq, lds, wid, lane); S.done(cur); }
#undef PG8_SA
#undef PG8_SB
#undef PG8_STAGE
#undef PG8_LDA
#undef PG8_LDB
#undef PG8_MMA
#undef PG8_WAIT_V
#undef PG8_WAIT_L
#undef PG8_BAR
#undef PG8_SCHED
}
}

#ifndef MK_N_LAUNCHES
#define MK_N_LAUNCHES 1
#endif
constexpr int M = 16384, D = 2048, FF = 5504, NMIX = 11264, CW = 1024, PLE = 256, SEQ = 4096, NHEAD = 8;
constexpr float LN_EPS = 1e-5f, RMS_EPS = 1e-6f;
constexpr float ALPHA = 1.18920711500272f;
constexpr int NWAVES = 8, NTHREADS = 512;
constexpr size_t HMiB = 1u << 19;
constexpr size_t WS_XN = 2 * HMiB;
constexpr size_t WS_W1IN = 130 * HMiB, WS_W1OUT = 220 * HMiB, WS_WMIX = 263 * HMiB, WS_WA = 351 * HMiB, WS_WB = 359 * HMiB, WS_WMO = 367 * HMiB, WS_WPG = 383 * HMiB, WS_WPP = 399 * HMiB;
constexpr int LDW1 = D + 64;
constexpr size_t WS_PB = 401 * HMiB;
constexpr size_t WS_DEC = 417 * HMiB;
constexpr size_t WS_BIG = 418 * HMiB;
constexpr size_t WS_H = WS_BIG;
constexpr size_t WS_Z = WS_BIG;
constexpr size_t ZSZ = (size_t)M * 1024;
constexpr size_t WS_T1 = WS_BIG + 128 * HMiB;
constexpr size_t WS_W2IN = WS_BIG + 344 * HMiB, WS_W2OUT = WS_W2IN + 86 * HMiB;
constexpr size_t WS_PP = WS_BIG;
constexpr size_t WS_END = WS_BIG + 640 * HMiB;
static_assert(WS_W1IN + (size_t)2 * FF * LDW1 * 2 <= WS_W1OUT && WS_W1OUT + (size_t)D * FF * 2 == WS_WMIX && WS_WMIX + (size_t)NMIX * D * 2 == WS_WA, "ws map 1");
static_assert(WS_WB + (size_t)D * CW * 2 == WS_WMO && WS_WMO + (size_t)D * D * 2 == WS_WPG && WS_WPP + (size_t)D * PLE * 2 == WS_PB && WS_PB + (size_t)M * PLE * 2 == WS_DEC, "ws map 2");
static_assert(WS_H + (size_t)M * FF * 2 == WS_W2IN && WS_W2OUT + (size_t)D * FF * 2 <= WS_END && WS_Z + 10 * ZSZ * 2 == WS_END && WS_XN + (size_t)M * D * 2 == WS_W1IN, "ws map 3");

#define LAS __attribute__((address_space(3)))
typedef unsigned short bf16;
typedef unsigned v4u __attribute__((ext_vector_type(4)));
typedef unsigned v2u __attribute__((ext_vector_type(2)));
typedef float f32x4 __attribute__((ext_vector_type(4)));
typedef short bf16x8 __attribute__((ext_vector_type(8)));
constexpr int LDS_BYTES = 131072 + 1024;
#define LDS_WAIT() asm volatile("s_waitcnt lgkmcnt(0)" ::: "memory")
#define LDS_BARRIER() do { asm volatile("s_waitcnt lgkmcnt(0)" ::: "memory"); __builtin_amdgcn_s_barrier(); asm volatile("" ::: "memory"); } while (0)
__device__ __forceinline__ unsigned pk2(float lo, float hi) { return pg8::cvt_pk_bf16(lo, hi); }
__device__ __forceinline__ float bf2f(bf16 v) { return __uint_as_float(((unsigned)v) << 16); }
__device__ __forceinline__ float wave_sum(float v) {
#pragma unroll
    for (int o = 1; o < 64; o <<= 1) v += __shfl_xor(v, o);
    return v;
}
__device__ __forceinline__ float fexp(float x) { return __builtin_amdgcn_exp2f(1.4426950408889634f * x); }

__device__ __forceinline__ int map_col(int kind, int n0) {
    if (kind == 0) return n0;
    const int tile = n0 >> 8, i = n0 & 255;
    if (kind == 1) return (i < 128) ? (tile * 128 + i) : (FF + tile * 128 + (i - 128));
    if (tile >= 4 && tile < 12) { const int q = tile - 4; return (i < 128) ? (1024 + q * 128 + i) : (2048 + q * 128 + (i - 128)); }
    return n0;
}
struct TJob { const float* W; bf16* WT; int K, N, k0, n0, sc, ldk; };
__device__ __forceinline__ TJob tjob(const float* W, int K, int N, bf16* WT, int kind, int item, int ldk = 0) {
    const int nblk = N / 32, kb = item / nblk, nb = item % nblk; TJob j; j.W = W; j.WT = WT; j.K = K; j.N = N; j.k0 = 64 * kb; j.n0 = 32 * nb; j.sc = map_col(kind, j.n0); j.ldk = ldk ? ldk : K; return j; }
#define TJ_LOAD(tv, j, lane) do { _Pragma("unroll") for (int i_ = 0; i_ < 32; ++i_) (tv)[i_] = __builtin_nontemporal_load((j).W + (size_t)((j).k0 + 2 * i_ + ((lane) >> 5)) * (j).N + (j).sc + ((lane) & 31)); } while (0)
__device__ __forceinline__ void tjob_finish(const TJob& j, const float (&tv)[32], LAS float* scr, int lane) {
#pragma unroll
    for (int i = 0; i < 32; ++i) scr[(2 * i + (lane >> 5)) * 33 + (lane & 31)] = tv[i];
    LDS_WAIT(); asm volatile("" ::: "memory");
    const int c = lane & 7;
#pragma unroll
    for (int jj = 0; jj < 4; ++jj) { const int n = (lane >> 3) + 8 * jj; const LAS float* s = scr + (8 * c) * 33 + n;
        v4u o; o.x = pk2(s[0 * 33], s[1 * 33]); o.y = pk2(s[2 * 33], s[3 * 33]); o.z = pk2(s[4 * 33], s[5 * 33]); o.w = pk2(s[6 * 33], s[7 * 33]);
        *(v4u*)(j.WT + (size_t)(j.n0 + n) * j.ldk + j.k0 + 8 * c) = o; }
    LDS_WAIT(); asm volatile("" ::: "memory");
}
__device__ __forceinline__ void cvt_copy(const float* src, bf16* dst, size_t n, size_t gt, size_t ngt) {
    size_t i = gt * 8;
    for (; i + 3 * ngt * 8 < n; i += 4 * ngt * 8) { f32x4 a[4], b[4];
#pragma unroll
        for (int u = 0; u < 4; ++u) { a[u] = *(const f32x4*)(src + i + u * ngt * 8); b[u] = *(const f32x4*)(src + i + u * ngt * 8 + 4); }
#pragma unroll
        for (int u = 0; u < 4; ++u) { v4u o; o.x = pk2(a[u][0], a[u][1]); o.y = pk2(a[u][2], a[u][3]); o.z = pk2(b[u][0], b[u][1]); o.w = pk2(b[u][2], b[u][3]); *(v4u*)(dst + i + u * ngt * 8) = o; } }
    for (; i < n; i += ngt * 8) { const f32x4 a = *(const f32x4*)(src + i), b = *(const f32x4*)(src + i + 4);
        v4u o; o.x = pk2(a[0], a[1]); o.y = pk2(a[2], a[3]); o.z = pk2(b[0], b[1]); o.w = pk2(b[2], b[3]); *(v4u*)(dst + i) = o; }
}
__device__ __forceinline__ void ln_pass(float* X, bf16* XN, pg8::f32x2* MR, const float* g, const float* b, int gw, int ngw, int lane, int row_end = M) {
    for (int row = gw; row < row_end; row += ngw) {
        f32x4* xr = (f32x4*)(X + (size_t)row * D) + lane;
        f32x4 v[8]; float s = 0.f;
#pragma unroll
        for (int j = 0; j < 8; ++j) { v[j] = xr[64 * j]; s += (v[j][0] + v[j][1]) + (v[j][2] + v[j][3]); }
        const float mean = wave_sum(s) * (1.f / D); float s2 = 0.f;
#pragma unroll
        for (int j = 0; j < 8; ++j) { v[j] = v[j] - mean; s2 += (v[j][0] * v[j][0] + v[j][1] * v[j][1]) + (v[j][2] * v[j][2] + v[j][3] * v[j][3]); }
        const float rstd = 1.f / sqrtf(wave_sum(s2) * (1.f / D) + LN_EPS);
#pragma unroll
        for (int j = 0; j < 8; ++j) { const f32x4 gg = ((const f32x4*)g)[lane + 64 * j], bb = ((const f32x4*)b)[lane + 64 * j]; const f32x4 y = v[j] * rstd * gg + bb;
            if (!MR) xr[64 * j] = y;
            if (XN) { v2u o; o.x = pk2(y[0], y[1]); o.y = pk2(y[2], y[3]); *(v2u*)(XN + (size_t)row * D + (size_t)(lane + 64 * j) * 4) = o; } }
        if (MR && lane == 0) MR[row] = (pg8::f32x2){mean, rstd};
    }
}
__device__ __forceinline__ void conv_pass(bf16* BB, const bf16* CH, const float* cw, int gt, int ngt, int gi_end = (M / 16) * 128) {
    for (int gi = gt; gi < gi_end; gi += ngt) {
        const int rg = gi >> 7, ch = gi & 127, r0 = rg * 16, c0 = ch * 8;
        float w0[8], w1[8], w2[8], p1[8], p2[8];
#pragma unroll
        for (int e = 0; e < 8; ++e) { w0[e] = cw[c0 + e]; w1[e] = cw[1024 + c0 + e]; w2[e] = cw[2048 + c0 + e]; p1[e] = 0.f; p2[e] = 0.f; }
        if ((r0 & (SEQ - 1)) != 0) { const v4u a = *(const v4u*)(CH + (size_t)(r0 - 2) * 1024 + c0), b = *(const v4u*)(CH + (size_t)(r0 - 1) * 1024 + c0);
#pragma unroll
            for (int e = 0; e < 4; ++e) { p2[2 * e] = pg8::bf_lo(a[e]); p2[2 * e + 1] = pg8::bf_hi(a[e]); p1[2 * e] = pg8::bf_lo(b[e]); p1[2 * e + 1] = pg8::bf_hi(b[e]); } }
#pragma unroll 4
        for (int r = 0; r < 16; ++r) { const size_t off = (size_t)(r0 + r) * 1024 + c0; const v4u cc = *(const v4u*)(CH + off), bv = *(const v4u*)(BB + off); float cu[8], y[8];
#pragma unroll
            for (int e = 0; e < 4; ++e) { cu[2 * e] = pg8::bf_lo(cc[e]); cu[2 * e + 1] = pg8::bf_hi(cc[e]); y[2 * e] = pg8::bf_lo(bv[e]); y[2 * e + 1] = pg8::bf_hi(bv[e]); }
#pragma unroll
            for (int e = 0; e < 8; ++e) { y[e] *= (w0[e] * p2[e] + w1[e] * p1[e] + w2[e] * cu[e]); p2[e] = p1[e]; p1[e] = cu[e]; }
            v4u o; o.x = pk2(y[0], y[1]); o.y = pk2(y[2], y[3]); o.z = pk2(y[4], y[5]); o.w = pk2(y[6], y[7]); *(v4u*)(BB + off) = o; }
    }
}

#define XB_TMO      128
#define XB_XCNT(j)  (256  + 64 * (j))
#define XB_XSUB(j)  (1280 + 64 * (j))
#define XB_XGEN(j)  (2304 + 64 * (j))
#define XB_TOP      3328
#define XB_TOPGEN   3392
#define XCD_BAR_WORDS 3456
#define XB_SPIN_CAP (1u << 18)

__device__ __forceinline__ unsigned xb_ld(unsigned* p)              { return __hip_atomic_load(p, __ATOMIC_RELAXED, __HIP_MEMORY_SCOPE_AGENT); }
__device__ __forceinline__ unsigned xb_add(unsigned* p, unsigned v) { return __hip_atomic_fetch_add(p, v, __ATOMIC_RELAXED, __HIP_MEMORY_SCOPE_AGENT); }
__device__ __forceinline__ unsigned xb_xcc_id() { return (unsigned)__builtin_amdgcn_s_getreg((3 << 11) | 20) & 0xFu; }
#define XB_SPIN(cond, bar) do { unsigned _sp = 0; while (cond) { __builtin_amdgcn_s_sleep(1); \
    if ((++_sp & 255u) == 0u) { if (xb_ld(&(bar)[XB_TMO])) break; if (_sp > XB_SPIN_CAP) { atomicAdd(&(bar)[XB_TMO], 1u); break; } } } } while (0)

struct XcdBarrier {
    unsigned* bar; unsigned x;
    volatile LAS unsigned* st;
};

__device__ __forceinline__ XcdBarrier xcd_barrier_post(unsigned* bar, volatile LAS unsigned* st) {
    XcdBarrier b; b.bar = bar; b.x = xb_xcc_id(); b.st = st;
    if (threadIdx.x == 0) (void)xb_add(&bar[XB_XCNT(b.x)], 1u);
    return b;
}
__device__ __forceinline__ void xcd_barrier_complete(unsigned* bar, unsigned x, unsigned& nloc, unsigned& nx) {
    const unsigned G = gridDim.x * gridDim.y * gridDim.z;
    unsigned sum, cnt, mine, sp = 0u;
    for (;;) {
        sum = 0u; cnt = 0u; mine = 0u;
#pragma unroll
        for (unsigned j = 0; j < 16; ++j) { const unsigned c = xb_ld(&bar[XB_XCNT(j)]); sum += c; cnt += (c > 0u) ? 1u : 0u; mine = (j == x) ? c : mine; }
        if (sum == G) break;
        __builtin_amdgcn_s_sleep(1);
        if ((++sp & 255u) == 0u) { if (xb_ld(&bar[XB_TMO])) break; if (sp > XB_SPIN_CAP) { atomicAdd(&bar[XB_TMO], 1u); break; } }
    }
    nloc = mine > 0u ? mine : 1u; nx = cnt > 0u ? cnt : 1u;
}

__device__ __forceinline__ void xcd_barrier(const XcdBarrier& b) {
    asm volatile("s_waitcnt vmcnt(0)" ::: "memory");
    __syncthreads();
    if (threadIdx.x == 0) {
        unsigned* bar = b.bar;
        __builtin_amdgcn_s_waitcnt(0);
        unsigned nloc = b.st[0], nx = b.st[1];
        if (nloc == 0u) { xcd_barrier_complete(bar, b.x, nloc, nx); b.st[0] = nloc; b.st[1] = nx; }
        const unsigned old = xb_add(&bar[XB_XSUB(b.x)], 1u);
        const unsigned gen = old / nloc;
        if (old + 1u == (gen + 1u) * nloc) {
            __builtin_amdgcn_fence(__ATOMIC_RELEASE, "agent");
            asm volatile("s_waitcnt vmcnt(0)" ::: "memory");
            const unsigned og = xb_add(&bar[XB_TOP], 1u);
            const unsigned tg = og / nx;
            if (og + 1u == (tg + 1u) * nx) xb_add(&bar[XB_TOPGEN], 1u);
            else XB_SPIN(xb_ld(&bar[XB_TOPGEN]) == tg, bar);
            __builtin_amdgcn_fence(__ATOMIC_ACQUIRE, "agent");
            xb_add(&bar[XB_XGEN(b.x)], 1u);
            asm volatile("s_waitcnt vmcnt(0)" ::: "memory");
        } else {
            XB_SPIN(xb_ld(&bar[XB_XGEN(b.x)]) == gen, bar);
            __builtin_amdgcn_fence(__ATOMIC_ACQUIRE, "agent");
            asm volatile("s_waitcnt vmcnt(0)" ::: "memory");
        }
    }
    __syncthreads();
}

struct HgPtrs { const bf16 *QB, *FB, *VB, *GB; bf16* YB; float* ST; float* DEC; const float* hlb; const float* nw; };
constexpr int HL_QR = 0, HL_FR = 8192, HL_GR = 16384, HL_VT = 24576, HL_QS = 34816, HL_KS = 43520, HL_KT = 52224, HL_SVT = 62464, HL_PS = 97280, HL_TOT = 99840, HL_EL = 101888, HL_SSQ = 102400, HL_OS = 103424;
template <int MODE> __device__ __forceinline__ void hgrn_phase(LAS unsigned char* lds, const HgPtrs& P, int first, int step, int tid, int last = 1024) {
    const int lt0 = tid >> 4, lc0 = tid & 15;
    v4u rf, rv, rq = (v4u){0u, 0u, 0u, 0u}, rg = (v4u){0u, 0u, 0u, 0u};
#define HG_LOAD(it_, sc_) do { const int bh_ = (it_) >> 5, j_ = (it_) & 31; const size_t go_ = (size_t)((bh_ >> 3) * SEQ + j_ * 128 + (sc_) * 32 + lt0) * 1024 + (bh_ & 7) * 128 + lc0 * 8; \
        rf = *(const v4u*)(P.FB + go_); rv = *(const v4u*)(P.VB + (size_t)((bh_ >> 3) * SEQ + j_ * 128 + (sc_) * 32 + (tid & 31)) * 1024 + (bh_ & 7) * 128 + (tid >> 5) * 8); if (MODE == 1) { rq = *(const v4u*)(P.QB + go_); rg = *(const v4u*)(P.GB + go_); } } while (0)
    if (first < last) HG_LOAD(first, 0);
  for (int item = first; item < last; item += step) {
    const int bh = item >> 5, j = item & 31, b = bh >> 3, h = bh & 7;
    const int row0 = b * SEQ + j * 128, col0 = h * 128;
    const int lane = tid & 63, w = __builtin_amdgcn_readfirstlane(tid >> 6), li = lane & 15, lg = lane >> 4;
    const int lt = tid >> 4, lc = tid & 15;
    const int pk = tid & 127, tq = tid >> 7;
    LAS bf16* QR = (LAS bf16*)(lds + HL_QR); LAS bf16* FR = (LAS bf16*)(lds + HL_FR); LAS bf16* GR = (LAS bf16*)(lds + HL_GR);
    LAS bf16* VT = (LAS bf16*)(lds + HL_VT); LAS bf16* QS = (LAS bf16*)(lds + HL_QS); LAS bf16* KS = (LAS bf16*)(lds + HL_KS);
    LAS bf16* KT = (LAS bf16*)(lds + HL_KT); LAS bf16* SVT = (LAS bf16*)(lds + HL_SVT); LAS bf16* PS = (LAS bf16*)(lds + HL_PS);
    LAS float* TOT = (LAS float*)(lds + HL_TOT); LAS float* EL = (LAS float*)(lds + HL_EL); LAS float* SSQ = (LAS float*)(lds + HL_SSQ); LAS bf16* OS = (LAS bf16*)(lds + HL_OS);
    const float oml = 1.f - 1.f / (1.f + fexp(P.hlb[1024 + col0 + pk] - P.hlb[col0 + pk]));
    float dtot = 1.f;
    f32x4 accS[8];
    float* stp = P.ST + (size_t)item * 16384 + (size_t)(16 * w + 4 * lg) * 128 + li;
#pragma unroll
    for (int vb = 0; vb < 8; ++vb) {
        if (MODE == 1) {
#pragma unroll
            for (int jj = 0; jj < 4; ++jj) accS[vb][jj] = stp[jj * 128 + 16 * vb];
            v2u o; o.x = pk2(accS[vb][0], accS[vb][1]); o.y = pk2(accS[vb][2], accS[vb][3]);
            *(LAS v2u*)(SVT + (16 * vb + li) * 136 + 16 * w + 4 * lg) = o;
        } else accS[vb] = (f32x4){0.f, 0.f, 0.f, 0.f};
    }
    for (int sc = 0; sc < 4; ++sc) {
        { const v4u vv = rv;
          *(LAS v4u*)(FR + lt * 128 + lc * 8) = rf;
#pragma unroll
          for (int e = 0; e < 4; ++e) { VT[((tid >> 5) * 8 + 2 * e) * 40 + (tid & 31)] = (bf16)(vv[e] & 0xffffu); VT[((tid >> 5) * 8 + 2 * e + 1) * 40 + (tid & 31)] = (bf16)(vv[e] >> 16); }
          if (MODE == 1) { *(LAS v4u*)(QR + lt * 128 + lc * 8) = rq; *(LAS v4u*)(GR + lt * 128 + lc * 8) = rg; }
          if (sc < 3) HG_LOAD(item, sc + 1); else if (item + step < last) HG_LOAD(item + step, 0); }
        LDS_BARRIER();
        float kk[8], cs[8]; float run = 0.f;
#pragma unroll
        for (int e = 0; e < 8; ++e) { const float fr = bf2f(FR[(8 * tq + e) * 128 + pk]); kk[e] = oml * __builtin_amdgcn_rcpf(1.f + fexp(fr)); run += __logf(1.f - kk[e]); cs[e] = run; }
        TOT[tq * 128 + pk] = run;
        LDS_BARRIER();
        { const float t0 = TOT[pk], t1 = TOT[128 + pk], t2 = TOT[256 + pk], t3 = TOT[384 + pk];
          const float pre = (tq > 0 ? t0 : 0.f) + (tq > 1 ? t1 : 0.f) + (tq > 2 ? t2 : 0.f), last = (t0 + t1) + (t2 + t3);
          float kt[8];
          const float elast = fexp(last);
#pragma unroll
          for (int e = 0; e < 8; ++e) { const float cum = pre + cs[e];
              if (MODE == 1) { const int t = 8 * tq + e; const float qr = bf2f(QR[t * 128 + pk]); const float kn = kk[e] * fexp(-cum); kt[e] = kn * elast;
                  QS[t * 136 + pk] = (bf16)(pk2(qr * pg8::sigm(qr) * fexp(cum), 0.f) & 0xffffu); KS[t * 136 + pk] = (bf16)(pk2(kn, 0.f) & 0xffffu); }
              else kt[e] = kk[e] * fexp(last - cum); }
          v4u o; o.x = pk2(kt[0], kt[1]); o.y = pk2(kt[2], kt[3]); o.z = pk2(kt[4], kt[5]); o.w = pk2(kt[6], kt[7]);
          *(LAS v4u*)(KT + pk * 40 + 8 * tq) = o;
          if (tq == 0) { EL[pk] = elast; dtot *= elast; } }
        LDS_BARRIER();
        f32x4 accO[2];
        if (MODE == 1) {
#pragma unroll
            for (int tb = 0; tb < 2; ++tb) { accO[tb] = (f32x4){0.f, 0.f, 0.f, 0.f};
#pragma unroll
                for (int kb = 0; kb < 4; ++kb) { const bf16x8 a = *(const LAS bf16x8*)(QS + (16 * tb + li) * 136 + 32 * kb + 8 * lg), bb = *(const LAS bf16x8*)(SVT + (16 * w + li) * 136 + 32 * kb + 8 * lg);
                    accO[tb] = __builtin_amdgcn_mfma_f32_16x16x32_bf16(a, bb, accO[tb], 0, 0, 0); } }
            if (w < 4) { const int tb = w >> 1, sb = w & 1; f32x4 sa = (f32x4){0.f, 0.f, 0.f, 0.f};
#pragma unroll
                for (int kb = 0; kb < 4; ++kb) { const bf16x8 a = *(const LAS bf16x8*)(QS + (16 * tb + li) * 136 + 32 * kb + 8 * lg), bb = *(const LAS bf16x8*)(KS + (16 * sb + li) * 136 + 32 * kb + 8 * lg);
                    sa = __builtin_amdgcn_mfma_f32_16x16x32_bf16(a, bb, sa, 0, 0, 0); }
#pragma unroll
                for (int jj = 0; jj < 4; ++jj) { const int t = 16 * tb + 4 * lg + jj, s = 16 * sb + li; PS[t * 40 + s] = (bf16)(pk2(s <= t ? sa[jj] : 0.f, 0.f) & 0xffffu); } }
            LDS_BARRIER();
#pragma unroll
            for (int tb = 0; tb < 2; ++tb) { const bf16x8 a = *(const LAS bf16x8*)(PS + (16 * tb + li) * 40 + 8 * lg), bb = *(const LAS bf16x8*)(VT + (16 * w + li) * 40 + 8 * lg);
                accO[tb] = __builtin_amdgcn_mfma_f32_16x16x32_bf16(a, bb, accO[tb], 0, 0, 0); }
        }
        { const bf16x8 a = *(const LAS bf16x8*)(KT + (16 * w + li) * 40 + 8 * lg); const f32x4 el = *(const LAS f32x4*)(EL + 16 * w + 4 * lg);
#pragma unroll
          for (int vb = 0; vb < 8; ++vb) { const bf16x8 bb = *(const LAS bf16x8*)(VT + (16 * vb + li) * 40 + 8 * lg);
              accS[vb] = __builtin_amdgcn_mfma_f32_16x16x32_bf16(a, bb, accS[vb] * el, 0, 0, 0);
              if (MODE == 1 && sc < 3) { v2u o; o.x = pk2(accS[vb][0], accS[vb][1]); o.y = pk2(accS[vb][2], accS[vb][3]); *(LAS v2u*)(SVT + (16 * vb + li) * 136 + 16 * w + 4 * lg) = o; } } }
        if (MODE == 1) {
#pragma unroll
            for (int tb = 0; tb < 2; ++tb)
#pragma unroll
                for (int jj = 0; jj < 4; ++jj) { float s2 = accO[tb][jj] * accO[tb][jj]; s2 += __shfl_xor(s2, 1); s2 += __shfl_xor(s2, 2); s2 += __shfl_xor(s2, 4); s2 += __shfl_xor(s2, 8);
                    if (li == 0) SSQ[(16 * tb + 4 * lg + jj) * 8 + w] = s2; }
            LDS_BARRIER();
            const float nwv = P.nw[16 * w + li];
#pragma unroll
            for (int tb = 0; tb < 2; ++tb)
#pragma unroll
                for (int jj = 0; jj < 4; ++jj) { const int t = 16 * tb + 4 * lg + jj; const f32x4 q0 = *(const LAS f32x4*)(SSQ + t * 8), q1 = *(const LAS f32x4*)(SSQ + t * 8 + 4);
                    const float ss = ((q0[0] + q0[1]) + (q0[2] + q0[3])) + ((q1[0] + q1[1]) + (q1[2] + q1[3]));
                    const float rstd = __builtin_amdgcn_rsqf(ss * (1.f / 128.f) + RMS_EPS); const float gr = bf2f(GR[t * 128 + 16 * w + li]);
                    OS[t * 128 + 16 * w + li] = (bf16)(pk2(accO[tb][jj] * rstd * nwv * gr * pg8::sigm(gr), 0.f) & 0xffffu); }
            LDS_BARRIER();
            *(v4u*)(P.YB + (size_t)(row0 + sc * 32 + lt) * 1024 + col0 + lc * 8) = *(const LAS v4u*)(OS + lt * 128 + lc * 8);
        } else {
            LDS_BARRIER();
        }
    }
    if (MODE == 0) {
#pragma unroll
        for (int vb = 0; vb < 8; ++vb)
#pragma unroll
            for (int jj = 0; jj < 4; ++jj) stp[jj * 128 + 16 * vb] = accS[vb][jj];
        if (tq == 0) P.DEC[(size_t)item * 128 + pk] = dtot;
    }
    LDS_BARRIER();
  }
#undef HG_LOAD
}

constexpr int H1_FR = 0, H1_VT = 32768, H1_KT = 67584, H1_TOT = 102400;
__device__ __forceinline__ void hgrn_pass1(LAS unsigned char* lds, const HgPtrs& P, int first, int step, int last, int tid) {
    LAS bf16* FRB = (LAS bf16*)(lds + H1_FR); LAS bf16* VT2 = (LAS bf16*)(lds + H1_VT); LAS bf16* KT2 = (LAS bf16*)(lds + H1_KT); LAS float* TOT2 = (LAS float*)(lds + H1_TOT);
    const int lane = tid & 63, w = __builtin_amdgcn_readfirstlane(tid >> 6), li = lane & 15, lg = lane >> 4;
    const int pk = tid & 127, tq = tid >> 7;
    v4u rf[4], rv[4];
#define H1_LOAD(it_) do { const int bh_ = (it_) >> 5, j_ = (it_) & 31; const size_t rb_ = (size_t)((bh_ >> 3) * SEQ + j_ * 128) * 1024 + (bh_ & 7) * 128; \
        _Pragma("unroll") for (int i_ = 0; i_ < 4; ++i_) { rf[i_] = *(const v4u*)(P.FB + rb_ + (size_t)((tid >> 4) + 32 * i_) * 1024 + (tid & 15) * 8); rv[i_] = *(const v4u*)(P.VB + rb_ + (size_t)((tid & 31) + 32 * i_) * 1024 + (tid >> 5) * 8); } } while (0)
    if (first < last) H1_LOAD(first);
    for (int item = first; item < last; item += step) {
        const int h = (item >> 5) & 7, col0 = h * 128;
        const float oml = 1.f - 1.f / (1.f + fexp(P.hlb[1024 + col0 + pk] - P.hlb[col0 + pk]));
#pragma unroll
        for (int i = 0; i < 4; ++i) { *(LAS v4u*)(FRB + ((tid >> 4) + 32 * i) * 128 + (tid & 15) * 8) = rf[i];
#pragma unroll
            for (int e = 0; e < 4; ++e) { VT2[((tid >> 5) * 8 + 2 * e) * 136 + (tid & 31) + 32 * i] = (bf16)(rv[i][e] & 0xffffu); VT2[((tid >> 5) * 8 + 2 * e + 1) * 136 + (tid & 31) + 32 * i] = (bf16)(rv[i][e] >> 16); } }
        if (item + step < last) H1_LOAD(item + step);
        LDS_BARRIER();
        float kk[32], lf[32]; float tot = 0.f;
#pragma unroll
        for (int e = 0; e < 32; ++e) { const float fr = bf2f(FRB[(32 * tq + e) * 128 + pk]); kk[e] = oml * __builtin_amdgcn_rcpf(1.f + fexp(fr)); lf[e] = __logf(1.f - kk[e]); tot += lf[e]; }
        TOT2[tq * 128 + pk] = tot;
        LDS_BARRIER();
        { const float t0 = TOT2[pk], t1 = TOT2[128 + pk], t2 = TOT2[256 + pk], t3 = TOT2[384 + pk];
          float sfx = (tq < 1 ? t1 : 0.f) + (tq < 2 ? t2 : 0.f) + (tq < 3 ? t3 : 0.f);
          if (tq == 0) P.DEC[(size_t)item * 128 + pk] = fexp((t0 + t1) + (t2 + t3));
#pragma unroll
          for (int i = 3; i >= 0; --i) { float kt[8];
#pragma unroll
              for (int e = 7; e >= 0; --e) { kt[e] = kk[8 * i + e] * fexp(sfx); sfx += lf[8 * i + e]; }
              v4u o; o.x = pk2(kt[0], kt[1]); o.y = pk2(kt[2], kt[3]); o.z = pk2(kt[4], kt[5]); o.w = pk2(kt[6], kt[7]);
              *(LAS v4u*)(KT2 + pk * 136 + 32 * tq + 8 * i) = o; } }
        LDS_BARRIER();
        f32x4 accS[8];
#pragma unroll
        for (int vb = 0; vb < 8; ++vb) accS[vb] = (f32x4){0.f, 0.f, 0.f, 0.f};
#pragma unroll
        for (int tb = 0; tb < 4; ++tb) { const bf16x8 a = *(const LAS bf16x8*)(KT2 + (16 * w + li) * 136 + 32 * tb + 8 * lg);
#pragma unroll
            for (int vb = 0; vb < 8; ++vb) { const bf16x8 bb = *(const LAS bf16x8*)(VT2 + (16 * vb + li) * 136 + 32 * tb + 8 * lg); accS[vb] = __builtin_amdgcn_mfma_f32_16x16x32_bf16(a, bb, accS[vb], 0, 0, 0); } }
        float* stp = P.ST + (size_t)item * 16384 + (size_t)(16 * w + 4 * lg) * 128 + li;
#pragma unroll
        for (int vb = 0; vb < 8; ++vb)
#pragma unroll
            for (int jj = 0; jj < 4; ++jj) stp[jj * 128 + 16 * vb] = accS[vb][jj];
        LDS_BARRIER();
    }
#undef H1_LOAD
}
__device__ __forceinline__ void hgrn_scan(float* ST, const float* DEC, int gt, int ngt) {
    for (int gi = gt; gi < 32 * 4096; gi += ngt) {
        const int bh = gi >> 12, i4 = gi & 4095, k = i4 >> 5;
        f32x4 S = (f32x4){0.f, 0.f, 0.f, 0.f}; f32x4 L[32]; float dd[32];
#pragma unroll
        for (int j = 0; j < 32; ++j) { L[j] = *((const f32x4*)(ST + (size_t)(bh * 32 + j) * 16384) + i4); dd[j] = DEC[(size_t)(bh * 32 + j) * 128 + k]; }
#pragma unroll
        for (int j = 0; j < 32; ++j) { *((f32x4*)(ST + (size_t)(bh * 32 + j) * 16384) + i4) = S; S = S * dd[j] + L[j]; }
    }
}

struct Args { const float* in[17]; float* out; unsigned char* ws; int ph_lo, ph_hi; };
static_assert(sizeof(Args) == 17 * 8 + 8 + 8 + 8, "Args has no padding");
constexpr int N_PHASES = 18;

__global__ void __launch_bounds__(NTHREADS, 2) mk_fwd(Args args) {
    extern __shared__ __attribute__((aligned(16))) unsigned char lds_raw[];
    LAS unsigned char* lds = (LAS unsigned char*)lds_raw;
    cg::grid_group grid = cg::this_grid();
    if (args.ph_lo < 0) grid.sync();
    const int wave = __builtin_amdgcn_readfirstlane(threadIdx.x >> 6);
    const int G = gridDim.x;
    int bx = blockIdx.x;
#ifndef MK_NO_VB
    { unsigned* rk = (unsigned*)args.ws + 4096; volatile LAS unsigned* M0 = (volatile LAS unsigned*)((LAS unsigned char*)lds_raw + 131072);
      if (threadIdx.x == 0) { const unsigned x = xb_xcc_id(); const unsigned r = xb_add(&rk[64 * x], 1u); unsigned sum, below, bad, sp = 0u;
          for (;;) { sum = 0u; below = 0u; bad = 0u;
#pragma unroll
              for (unsigned j = 0; j < 16; ++j) { const unsigned c = xb_ld(&rk[64 * j]); sum += c; bad |= (c != 0u && c != (unsigned)G / 8u) ? 1u : 0u; below += (c != 0u && j < x) ? 1u : 0u; }
              if (sum == (unsigned)G) break;
              __builtin_amdgcn_s_sleep(2); if (++sp > (1u << 20)) { bad = 1u; break; } }
          M0[100] = (bad || (G & 7)) ? (unsigned)blockIdx.x : (below + 8u * r); }
      __syncthreads(); bx = __builtin_amdgcn_readfirstlane((int)M0[100]); __syncthreads(); }
#endif
    const int gw = bx * NWAVES + wave, ngw = G * NWAVES;
    const bool xl = (G == 256); const int xr0 = 2048 * (bx & 7) + 64 * (bx >> 3);
    const int hg_first = xl ? ((((bx & 7) >> 1) * 8 + 4 * ((bx >> 3) & 1)) * 32 + 16 * (bx & 1) + (bx >> 4)) : bx, hg_step = xl ? 32 : G, hg_last = xl ? hg_first + 128 : 1024;
    const int ngt = G * NTHREADS;
#define FRESH() int tid = threadIdx.x; asm volatile("" : "+v"(tid)); const int lane = tid & 63; const int gt = bx * NTHREADS + tid; (void)lane; (void)gt
    unsigned char* ws = args.ws;
    const float* x = args.in[0]; const float* pin = args.in[1]; const float* ln_g = args.in[2]; const float* ln_b = args.in[3];
    float* out = args.out;
    bf16* XN = (bf16*)(ws + WS_XN); bf16* HB = (bf16*)(ws + WS_H); bf16* Z = (bf16*)(ws + WS_Z); bf16* PB = (bf16*)(ws + WS_PB);
    bf16* W1IN = (bf16*)(ws + WS_W1IN); bf16* W1OUT = (bf16*)(ws + WS_W1OUT); bf16* WMIX = (bf16*)(ws + WS_WMIX); bf16* WA = (bf16*)(ws + WS_WA); bf16* WB = (bf16*)(ws + WS_WB);
    bf16* WMO = (bf16*)(ws + WS_WMO); bf16* WPG = (bf16*)(ws + WS_WPG); bf16* WPP = (bf16*)(ws + WS_WPP); bf16* W2IN = (bf16*)(ws + WS_W2IN); bf16* W2OUT = (bf16*)(ws + WS_W2OUT);
    float* ST = (float*)(ws + WS_XN); pg8::f32x2* MUR = (pg8::f32x2*)(ws + 65536);
#ifdef MK_MGALT
    bf16* MG = (bf16*)(ws + WS_BIG + 128 * HMiB);
#else
    bf16* MG = (bf16*)(ws + WS_XN);
#endif
    float* DEC = (float*)(ws + WS_DEC); bf16* T1 = (bf16*)(ws + WS_T1); bf16* PP = (bf16*)(ws + WS_PP);
    bf16* SGC = Z + 6 * ZSZ; bf16* SGH = Z + 8 * ZSZ;
    const int lo = args.ph_lo, hi = args.ph_hi;
    volatile LAS unsigned* MISC = (volatile LAS unsigned*)(lds + 131072);
    if (threadIdx.x < 64) MISC[threadIdx.x] = 0u;
    __syncthreads();
    const XcdBarrier bar = xcd_barrier_post((unsigned*)ws, MISC + 8);
#ifndef MK_DBL
#define MK_DBL 0
#endif
#ifndef MK_ALIGN
#define MK_ALIGN true
#endif
#ifndef MK_DSEAM
#define MK_DSEAM 0
#endif
#ifndef MK_WG_K5504
#define MK_WG_K5504 MK_WGM
#endif
#ifndef MK_WG_N2048
#define MK_WG_N2048 MK_WGM
#endif
#ifndef MK_SP2
#define MK_SP2 true
#endif
#define NREP(k) ((((MK_DBL) >> (k)) & 1) ? 2 : 1)
#define IN(k) (lo <= (k) && (k) < hi)
#define SEAM(k) do { if (IN(k) && IN((k) + 1)) { { xcd_barrier(bar); if (MK_DSEAM) xcd_barrier(bar); } } } while (0)
    LAS float* scr = (LAS float*)(lds + wave * 16384);

    if (IN(0)) for (int rep = 0; rep < NREP(0); ++rep) { FRESH();
        constexpr int I0 = (D / 64) * (2 * FF / 32), I1 = (FF / 64) * (D / 32), I2 = (D / 64) * (NMIX / 32), I3 = (CW / 64) * (D / 32), I4 = (D / 64) * (D / 32), I5 = (PLE / 64) * (D / 32);
        constexpr int NIT = I0 + I1 + I2 + 2 * I3 + 2 * I4 + I5;
#define P0_JOB(J, it_) do { int r = (it_); \
            if (r < I0) { J = tjob(args.in[4], D, 2 * FF, W1IN, 1, r, LDW1); break; } r -= I0; \
            if (r < I1) { J = tjob(args.in[5], FF, D, W1OUT, 0, r); break; } r -= I1; \
            if (r < I2) { J = tjob(args.in[6], D, NMIX, WMIX, 2, r); break; } r -= I2; \
            if (r < I3) { J = tjob(args.in[10], CW, D, WA, 0, r); break; } r -= I3; \
            if (r < I3) { J = tjob(args.in[11], CW, D, WB, 0, r); break; } r -= I3; \
            if (r < I4) { J = tjob(args.in[12], D, D, WMO, 0, r); break; } r -= I4; \
            if (r < I4) { J = tjob(args.in[15], D, D, WPG, 0, r); break; } r -= I4; \
            J = tjob(args.in[16], PLE, D, WPP, 0, r); } while (0)
        { TJob ja, jb; float ta[32], tb[32];
          int it = gw; if (it < NIT) { P0_JOB(ja, it); TJ_LOAD(ta, ja, lane); }
          for (; it < NIT; it += 2 * ngw) {
              const bool hb = it + ngw < NIT; if (hb) { P0_JOB(jb, it + ngw); TJ_LOAD(tb, jb, lane); }
              tjob_finish(ja, ta, scr, lane);
              const bool ha = it + 2 * ngw < NIT; if (ha) { P0_JOB(ja, it + 2 * ngw); TJ_LOAD(ta, ja, lane); }
              if (hb) tjob_finish(jb, tb, scr, lane); } }
#undef P0_JOB
        cvt_copy(x, XN, (size_t)M * D, gt, ngt);
        cvt_copy(pin, PB, (size_t)M * PLE, gt, ngt);
        __syncthreads();
    }
    SEAM(0);
    if (IN(1)) for (int rep = 0; rep < NREP(1); ++rep) { pg8::Gemm g{XN, W1IN, M, 2 * FF, D, 0, LDW1}; pg8::StaticOrder S; S.init(M, 2 * FF, G, bx); pg8::EpiSwiGLU E{HB, FF};
        pg8::gemm_phase<pg8::EpiSwiGLU, pg8::StaticOrder, MK_ALIGN, MK_SP2>(lds, g, S, E); }
    SEAM(1);
    if (IN(2)) for (int rep = 0; rep < NREP(2); ++rep) { pg8::Gemm g{HB, W1OUT, M, D, FF}; pg8::StaticOrder S; S.init(M, D, G, bx, MK_WG_K5504); pg8::EpiResid E{x, out, ALPHA, 0.5f};
        pg8::gemm_phase<pg8::EpiResid, pg8::StaticOrder, MK_ALIGN, MK_SP2>(lds, g, S, E); }
    SEAM(2);
    if (IN(3)) { FRESH(); ln_pass(out, XN, MUR, ln_g, ln_b, xl ? xr0 + 8 * wave : gw, xl ? 1 : ngw, lane, xl ? xr0 + 8 * wave + 8 : M); }
    SEAM(3);
    if (IN(4)) for (int rep = 0; rep < NREP(4); ++rep) { pg8::Gemm g{XN, WMIX, M, NMIX, D}; pg8::StaticOrder S; S.init(M, NMIX, G, bx); pg8::EpiMix E{Z, ZSZ};
        pg8::gemm_phase<pg8::EpiMix, pg8::StaticOrder, MK_ALIGN, MK_SP2>(lds, g, S, E); }
    SEAM(4);
    HgPtrs HP{Z + 2 * ZSZ, Z + 3 * ZSZ, Z + 4 * ZSZ, Z + 5 * ZSZ, Z + ZSZ, ST, DEC, args.in[8], args.in[9]};
    if (IN(5)) { FRESH(); { const int cg0 = ((xr0 >> 4) + (tid >> 7)) * 128 + (tid & 127); conv_pass(Z, Z + ZSZ, args.in[7], xl ? cg0 : gt, xl ? 1 : ngt, xl ? cg0 + 1 : (M / 16) * 128); }
#ifndef MK_SKIPHG
        for (int rep = 0; rep < NREP(5); ++rep) hgrn_pass1(lds, HP, hg_first, hg_step, hg_last, tid);
#endif
    }
    SEAM(5);
#ifndef MK_SKIPHG
    if (IN(6)) { FRESH(); hgrn_scan(ST, DEC, gt, ngt); }
#endif
    SEAM(6);
#ifndef MK_SKIPHG
    if (IN(7)) { FRESH(); for (int rep = 0; rep < NREP(7); ++rep) hgrn_phase<1>(lds, HP, hg_first, hg_step, tid, hg_last); }
#else
#ifdef MK_YBSUM
    if (IN(7)) { FRESH(); for (size_t i = (size_t)gt * 8; i < ZSZ; i += (size_t)ngt * 8) { const v4u a = *(const v4u*)(Z + 2 * ZSZ + i), b = *(const v4u*)(Z + 3 * ZSZ + i), c = *(const v4u*)(Z + 4 * ZSZ + i), d = *(const v4u*)(Z + 5 * ZSZ + i); v4u o;
#pragma unroll
        for (int e = 0; e < 4; ++e) o[e] = pk2(0.25f * (pg8::bf_lo(a[e]) + pg8::bf_lo(b[e]) + pg8::bf_lo(c[e]) + pg8::bf_lo(d[e])), 0.25f * (pg8::bf_hi(a[e]) + pg8::bf_hi(b[e]) + pg8::bf_hi(c[e]) + pg8::bf_hi(d[e])));
        *(v4u*)(Z + ZSZ + i) = o; } }
#else
    if (IN(7)) { FRESH(); for (size_t i = (size_t)gt * 8; i < ZSZ; i += (size_t)ngt * 8) *(v4u*)(Z + ZSZ + i) = (v4u){0u, 0u, 0u, 0u}; }
#endif
#endif
    SEAM(7);
#ifndef MK_SKIPBR
    if (IN(8)) { pg8::Gemm g{Z, WA, M, D, CW}; pg8::StaticOrder S; S.init(M, D, G, bx, MK_WG_N2048); pg8::EpiBr1 E{SGC, T1};
        pg8::gemm_phase<pg8::EpiBr1, pg8::StaticOrder, MK_ALIGN, MK_SP2>(lds, g, S, E); }
#ifdef MK_SEAM8
    SEAM(8);
#endif
    if (IN(9)) { pg8::Gemm g{Z + ZSZ, WB, M, D, CW}; pg8::StaticOrder S; S.init(M, D, G, bx, MK_WG_N2048); pg8::EpiBr2 E{SGH, T1, MG};
        pg8::gemm_phase<pg8::EpiBr2, pg8::StaticOrder, MK_ALIGN, MK_SP2>(lds, g, S, E); }
#else
#ifdef MK_GATESUM
    if (IN(9)) { FRESH(); for (size_t i = (size_t)gt * 8; i < (size_t)M * D; i += (size_t)ngt * 8) { const size_t row = i >> 11, c = i & 2047; const v4u a = *(const v4u*)(Z + row * 1024 + (c & 1023)), g1 = *(const v4u*)(SGC + i), g2 = *(const v4u*)(SGH + i); v4u o;
#pragma unroll
        for (int e = 0; e < 4; ++e) o[e] = pk2(pg8::bf_lo(a[e]) * pg8::bf_lo(g1[e]) + pg8::bf_lo(g2[e]), pg8::bf_hi(a[e]) * pg8::bf_hi(g1[e]) + pg8::bf_hi(g2[e]));
        *(v4u*)(MG + i) = o; } }
#else
    if (IN(9)) { FRESH(); for (size_t i = (size_t)gt * 8; i < (size_t)M * D; i += (size_t)ngt * 8) { const size_t row = i >> 11, c = i & 2047; *(v4u*)(MG + i) = *(const v4u*)(Z + (c >> 10) * ZSZ + row * 1024 + (c & 1023)); } }
#endif
#endif
    SEAM(9);
    if (IN(10)) { FRESH();
        constexpr int I0 = (D / 64) * (2 * FF / 32), I1 = (FF / 64) * (D / 32);
#ifndef MK_NOCONV10
#define P10_JOB(J, it_) do { if ((it_) < I0) J = tjob(args.in[13], D, 2 * FF, W2IN, 1, (it_)); else J = tjob(args.in[14], FF, D, W2OUT, 0, (it_) - I0); } while (0)
        { TJob ja, jb; float ta[32], tb[32]; constexpr int NIT2 = I0 + I1;
          int it = gw; if (it < NIT2) { P10_JOB(ja, it); TJ_LOAD(ta, ja, lane); }
          for (; it < NIT2; it += 2 * ngw) {
              const bool hb = it + ngw < NIT2; if (hb) { P10_JOB(jb, it + ngw); TJ_LOAD(tb, jb, lane); }
              tjob_finish(ja, ta, scr, lane);
              const bool ha = it + 2 * ngw < NIT2; if (ha) { P10_JOB(ja, it + 2 * ngw); TJ_LOAD(ta, ja, lane); }
              if (hb) tjob_finish(jb, tb, scr, lane); } }
#undef P10_JOB
#endif
        __syncthreads();
        pg8::Gemm g{MG, WMO, M, D, D}; pg8::StaticOrder S; S.init(M, D, G, bx, MK_WG_N2048); pg8::EpiResidLN E{out, MUR, ln_g, ln_b, ALPHA, 1.0f};
        pg8::gemm_phase<pg8::EpiResidLN, pg8::StaticOrder, MK_ALIGN, MK_SP2>(lds, g, S, E); }
    SEAM(10);
    if (IN(11)) { FRESH(); ln_pass(out, XN, MUR, ln_g + D, ln_b + D, xl ? xr0 + 8 * wave : gw, xl ? 1 : ngw, lane, xl ? xr0 + 8 * wave + 8 : M); }
    SEAM(11);
    if (IN(12)) { pg8::Gemm g{XN, W2IN, M, 2 * FF, D}; pg8::StaticOrder S; S.init(M, 2 * FF, G, bx); pg8::EpiSwiGLU E{HB, FF};
        pg8::gemm_phase<pg8::EpiSwiGLU, pg8::StaticOrder, MK_ALIGN, MK_SP2>(lds, g, S, E); }
    SEAM(12);
    if (IN(13)) { pg8::Gemm g{HB, W2OUT, M, D, FF}; pg8::StaticOrder S; S.init(M, D, G, bx, MK_WG_K5504); pg8::EpiResidLN E{out, MUR, ln_g + D, ln_b + D, ALPHA, 0.5f};
        pg8::gemm_phase<pg8::EpiResidLN, pg8::StaticOrder, MK_ALIGN, MK_SP2>(lds, g, S, E); }
    SEAM(13);
    if (IN(14)) { FRESH(); ln_pass(out, XN, MUR, ln_g + 2 * D, ln_b + 2 * D, xl ? xr0 + 8 * wave : gw, xl ? 1 : ngw, lane, xl ? xr0 + 8 * wave + 8 : M); }
    SEAM(14);
    if (IN(15)) { int kple = PLE; asm volatile("" : "+s"(kple));
        pg8::Gemm g{PB, WPP, M, D, kple}; pg8::StaticOrder S; S.init(M, D, G, bx, MK_WG_N2048); pg8::EpiF32P E{PP};
        pg8::gemm_phase<pg8::EpiF32P, pg8::StaticOrder, MK_ALIGN, MK_SP2>(lds, g, S, E); }
    if (IN(16)) { pg8::Gemm g{XN, WPG, M, D, D}; pg8::StaticOrder S; S.init(M, D, G, bx, MK_WG_N2048); pg8::EpiPleLN E{PP, out, MUR, ln_g + 2 * D, ln_b + 2 * D, ALPHA};
        pg8::gemm_phase<pg8::EpiPleLN, pg8::StaticOrder, MK_ALIGN, MK_SP2>(lds, g, S, E); }
    SEAM(16);
    if (IN(17)) { FRESH(); ln_pass(out, (bf16*)nullptr, (pg8::f32x2*)nullptr, ln_g + 3 * D, ln_b + 3 * D, xl ? xr0 + 8 * wave : gw, xl ? 1 : ngw, lane, xl ? xr0 + 8 * wave + 8 : M); }
#undef IN
#undef SEAM
#undef FRESH
}

extern "C" void kernel_launch(void* const* d_in, const int* in_sizes, int n_in, void* d_out, int out_size, void* d_ws, size_t ws_size, hipStream_t stream) {
    static int grid = 0;
    if (grid == 0) {
        if (n_in != 17 || in_sizes[0] != M * D || out_size != M * D || ws_size < WS_END) { fprintf(stderr, "kernel_launch: unexpected shapes (n_in %d, in0 %d, out %d, ws %zu < %zu)\n", n_in, n_in > 0 ? in_sizes[0] : -1, out_size, ws_size, (size_t)WS_END); grid = -1; return; }
        int dev = 0, cus = 0, per_cu = 0;
        (void)hipGetDevice(&dev); (void)hipDeviceGetAttribute(&cus, hipDeviceAttributeMultiprocessorCount, dev);
        if (hipFuncSetAttribute((const void*)mk_fwd, hipFuncAttributeMaxDynamicSharedMemorySize, LDS_BYTES) != hipSuccess) { fprintf(stderr, "kernel_launch: hipFuncSetAttribute failed\n"); grid = -1; return; }
        if (hipOccupancyMaxActiveBlocksPerMultiprocessor(&per_cu, (const void*)mk_fwd, NTHREADS, LDS_BYTES) != hipSuccess || per_cu < 1) { fprintf(stderr, "kernel_launch: occupancy query says %d\n", per_cu); per_cu = 1; }
        (void)hipGetLastError();
        grid = cus * per_cu;
    }
    if (grid < 0) return;
#ifdef MK_POISON
    (void)hipMemsetAsync(d_ws, 0xFF, WS_END, stream); (void)hipMemsetAsync(d_out, 0xFF, (size_t)M * D * 4, stream);
#endif
    if (hipMemsetAsync(d_ws, 0, 32768, stream) != hipSuccess) { fprintf(stderr, "kernel_launch: memset of the barrier words failed\n"); return; }
    Args a{};
    for (int i = 0; i < 17; ++i) a.in[i] = (const float*)d_in[i];
    a.out = (float*)d_out; a.ws = (unsigned char*)d_ws;
    void* kargs[] = {&a};
#if MK_N_LAUNCHES == 1
#ifdef MK_STOP
    a.ph_lo = 0; a.ph_hi = MK_STOP;
#else
    a.ph_lo = 0; a.ph_hi = N_PHASES;
#endif
    hipError_t e = hipLaunchCooperativeKernel((const void*)mk_fwd, dim3(grid), dim3(NTHREADS), kargs, LDS_BYTES, stream);
    if (e != hipSuccess) fprintf(stderr, "kernel_launch: cooperative launch failed: %s (grid %d)\n", hipGetErrorString(e), grid);
#else
    const int cuts[] = {0, 1, 2, 3, 4, 5, 6, 7, 8, 10, 11, 12, 13, 14, 15, 17, 18};
    for (int li = 0; li + 1 < (int)(sizeof(cuts) / sizeof(cuts[0])); ++li) {
        a.ph_lo = cuts[li]; a.ph_hi = cuts[li + 1];
        hipError_t e = hipLaunchCooperativeKernel((const void*)mk_fwd, dim3(grid), dim3(NTHREADS), kargs, LDS_BYTES, stream);
        if (e != hipSuccess) { fprintf(stderr, "kernel_launch: launch %d failed: %s (grid %d)\n", li, hipGetErrorString(e), grid); break; }
    }
#endif
}
```

```cpp
#define MK_N_LAUNCHES 1
#define MK_WGM 4
#include <hip/hip_runtime.h>
#include <hip/hip_cooperative_groups.h>
#include <cstdio>
#include <cstdint>
namespace cg = cooperative_groups;
namespace pg8 {
#define PG8_LAS __attribute__((address_space(3)))
typedef unsigned short bf16_t;
typedef short bf16x8 __attribute__((ext_vector_type(8)));
typedef float f32x4 __attribute__((ext_vector_type(4)));
typedef unsigned u32x4 __attribute__((ext_vector_type(4)));
constexpr int BM = 256, BK = 64, HALF = 128, HTB = HALF * BK * 2  , STAGE_BYTES = 8 * HTB, NXCD = 8, WGM = MK_WGM;

__host__ __device__ __forceinline__ int lds_byte(int r, int c) { const int st = (r >> 4) * 2 + (c >> 5), rr = r & 15, cc = c & 31, ob = rr * 64 + cc * 2; return st * 1024 + (ob ^ (((ob >> 9) & 1) << 5)); }
__host__ __device__ __forceinline__ void stage_rc(int b, int& R, int& C) { const int st = b / 1024, sb = b % 1024, swz = sb ^ (((sb >> 9) & 1) << 5); R = (st >> 1) * 16 + swz / 64; C = (st & 1) * 32 + (swz % 64) / 2; }
__host__ __device__ __forceinline__ int perm32(int rho) { const int n = rho >> 4, i = rho & 15; return 8 * (i >> 2) + 4 * n + (i & 3); }

struct Unit { int pm, pn; };
struct Gemm { const bf16_t* A; const bf16_t* Bt; int M, N, K; };

struct StaticOrder {
    int nM, nN, nwg, G, c, wgm;
    __host__ __device__ void init(int M, int N, int G_, int c_, int wgm_ = WGM) { nM = M / BM; nN = N / BM; nwg = nM * nN; G = G_; c = c_; wgm = wgm_; }
    __host__ __device__ bool next(int i, Unit& u) const {
        const long L = (long)i * G + c; if (L >= nwg) return false;
        int wgid = (int)L; { const int q = nwg / NXCD, r = nwg % NXCD, xcd = wgid % NXCD, off = wgid / NXCD; wgid = (xcd < r ? xcd * (q + 1) : r * (q + 1) + (xcd - r) * q) + off; }
        const int nig = wgm * nN, gid = wgid / nig, fm = gid * wgm, gsz = (nM - fm) < wgm ? (nM - fm) : wgm;
        u.pm = fm + ((wgid % nig) % gsz); u.pn = (wgid % nig) / gsz; return true;
    }
    __device__ __forceinline__ void a_ready(const Unit&) const {}
    __device__ __forceinline__ void done(const Unit&) const {}
};
typedef __bf16 bf16v2_t __attribute__((ext_vector_type(2)));
typedef float f32x2 __attribute__((ext_vector_type(2)));
__device__ __forceinline__ unsigned cvt_pk_bf16(float lo, float hi) { const f32x2 v = {lo, hi}; const bf16v2_t r = __builtin_convertvector(v, bf16v2_t); return __builtin_bit_cast(unsigned, r); }
__device__ __forceinline__ float bf_lo(unsigned w) { return __uint_as_float(w << 16); }
__device__ __forceinline__ float bf_hi(unsigned w) { return __uint_as_float(w & 0xffff0000u); }
__device__ __forceinline__ float sigm(float x) { return __builtin_amdgcn_rcpf(1.0f + __builtin_amdgcn_exp2f(-1.4426950408889634f * x)); }
__device__ __forceinline__ u32x4 pack8(const f32x4 v0, const f32x4 v1) { u32x4 w; w.x = cvt_pk_bf16(v0[0], v0[1]); w.y = cvt_pk_bf16(v0[2], v0[3]); w.z = cvt_pk_bf16(v1[0], v1[1]); w.w = cvt_pk_bf16(v1[2], v1[3]); return w; }

struct EpiSwiGLU {
    static constexpr bool PERM = true, AFTER_DRAIN = false;
    bf16_t* H; int ldc;
    __device__ __forceinline__ void operator()(const f32x4 (&acc)[2][2][4][2], const Unit& u, int wr, int wc, int fr, int fq) const {
        const int row0 = u.pm * BM + wr * 64 + fr, col0 = u.pn * HALF + wc * 32 + 8 * fq;
#pragma unroll
        for (int ai = 0; ai < 2; ++ai)
#pragma unroll
            for (int m = 0; m < 4; ++m) { bf16_t* rowp = H + (size_t)(row0 + ai * HALF + m * 16) * ldc + col0;
                f32x4 h0, h1;
#pragma unroll
                for (int j = 0; j < 4; ++j) { const float a0 = acc[ai][0][m][0][j], a1 = acc[ai][0][m][1][j]; h0[j] = a0 * sigm(a0) * acc[ai][1][m][0][j]; h1[j] = a1 * sigm(a1) * acc[ai][1][m][1][j]; }
                *(u32x4*)rowp = pack8(h0, h1); }
    }
};
struct EpiResid {
    static constexpr bool PERM = true, AFTER_DRAIN = false;
    const float* res; float* out; float alpha, scale;
    __device__ __forceinline__ void operator()(const f32x4 (&acc)[2][2][4][2], const Unit& u, int wr, int wc, int fr, int fq) const {
        const int row0 = u.pm * BM + wr * 64 + fr, col0 = u.pn * BM + wc * 32 + 8 * fq;
#pragma unroll
        for (int ai = 0; ai < 2; ++ai)
#pragma unroll
            for (int m = 0; m < 4; ++m) { const size_t off = (size_t)(row0 + ai * HALF + m * 16) * 2048 + col0;
#pragma unroll
                for (int bj = 0; bj < 2; ++bj)
#pragma unroll
                    for (int n = 0; n < 2; ++n) { const f32x4 r = *(const f32x4*)(res + off + bj * HALF + 4 * n); *(f32x4*)(out + off + bj * HALF + 4 * n) = r * alpha + acc[ai][bj][m][n] * scale; }
                asm volatile("" ::: "memory"); }
    }
};
struct EpiMix {
    static constexpr bool PERM = true, AFTER_DRAIN = false;
    bf16_t* Z; size_t SZ;
    __device__ __forceinline__ void operator()(const f32x4 (&acc)[2][2][4][2], const Unit& u, int wr, int wc, int fr, int fq) const {
        const int pn = u.pn; int mode, ldc, cb; bf16_t* dst;
        if (pn < 4) { mode = 0; dst = Z; ldc = 1024; cb = 256 * pn; }
        else if (pn < 12) { mode = 1; dst = Z + SZ; ldc = 1024; cb = 128 * (pn - 4); }
        else if (pn < 28) { mode = 0; dst = Z + (size_t)(2 + ((pn - 12) >> 2)) * SZ; ldc = 1024; cb = 256 * ((pn - 12) & 3); }
        else { mode = 2; dst = Z + (size_t)(6 + 2 * ((pn - 28) >> 3)) * SZ; ldc = 2048; cb = 256 * ((pn - 28) & 7); }
        const int row0 = u.pm * BM + wr * 64 + fr, col0 = cb + wc * 32 + 8 * fq;
        if (mode == 1) {
#pragma unroll
            for (int ai = 0; ai < 2; ++ai)
#pragma unroll
                for (int m = 0; m < 4; ++m) { bf16_t* rowp = dst + (size_t)(row0 + ai * HALF + m * 16) * ldc + col0;
                    *(u32x4*)rowp = pack8(acc[ai][0][m][0] * acc[ai][1][m][0], acc[ai][0][m][1] * acc[ai][1][m][1]); }
        } else if (mode == 0) {
#pragma unroll
            for (int ai = 0; ai < 2; ++ai)
#pragma unroll
                for (int m = 0; m < 4; ++m) { bf16_t* rowp = dst + (size_t)(row0 + ai * HALF + m * 16) * ldc + col0;
#pragma unroll
                    for (int bj = 0; bj < 2; ++bj) *(u32x4*)(rowp + bj * HALF) = pack8(acc[ai][bj][m][0], acc[ai][bj][m][1]); }
        } else {
#pragma unroll
            for (int ai = 0; ai < 2; ++ai)
#pragma unroll
                for (int m = 0; m < 4; ++m) { bf16_t* rowp = dst + (size_t)(row0 + ai * HALF + m * 16) * ldc + col0;
#pragma unroll
                    for (int bj = 0; bj < 2; ++bj) { f32x4 s0, s1;
#pragma unroll
#ifdef MK_NOSIG
                        for (int j = 0; j < 4; ++j) { s0[j] = acc[ai][bj][m][0][j]; s1[j] = acc[ai][bj][m][1][j]; }
#else
                        for (int j = 0; j < 4; ++j) { s0[j] = sigm(acc[ai][bj][m][0][j]); s1[j] = sigm(acc[ai][bj][m][1][j]); }
#endif
                        *(u32x4*)(rowp + bj * HALF) = pack8(s0, s1); } }
        }
    }
};
struct EpiBr1 {
    static constexpr bool PERM = true, AFTER_DRAIN = false;
    const bf16_t* sg; bf16_t* T1;
    __device__ __forceinline__ void operator()(const f32x4 (&acc)[2][2][4][2], const Unit& u, int wr, int wc, int fr, int fq) const {
        const int row0 = u.pm * BM + wr * 64 + fr, col0 = u.pn * BM + wc * 32 + 8 * fq;
#pragma unroll
        for (int ai = 0; ai < 2; ++ai)
#pragma unroll
            for (int m = 0; m < 4; ++m) { const size_t off = (size_t)(row0 + ai * HALF + m * 16) * 2048 + col0;
#pragma unroll
                for (int bj = 0; bj < 2; ++bj) { const u32x4 s = *(const u32x4*)(sg + off + bj * HALF);
                    const f32x4 g0 = (f32x4){bf_lo(s.x), bf_hi(s.x), bf_lo(s.y), bf_hi(s.y)}, g1 = (f32x4){bf_lo(s.z), bf_hi(s.z), bf_lo(s.w), bf_hi(s.w)};
                    *(u32x4*)(T1 + off + bj * HALF) = pack8(g0 * acc[ai][bj][m][0], g1 * acc[ai][bj][m][1]); }
                asm volatile("" ::: "memory"); }
    }
};
struct EpiBr2 {
    static constexpr bool PERM = true, AFTER_DRAIN = false;
    const bf16_t* sg; const bf16_t* T1; bf16_t* MG;
    __device__ __forceinline__ void operator()(const f32x4 (&acc)[2][2][4][2], const Unit& u, int wr, int wc, int fr, int fq) const {
        const int row0 = u.pm * BM + wr * 64 + fr, col0 = u.pn * BM + wc * 32 + 8 * fq;
#pragma unroll
        for (int ai = 0; ai < 2; ++ai)
#pragma unroll
            for (int m = 0; m < 4; ++m) { const size_t off = (size_t)(row0 + ai * HALF + m * 16) * 2048 + col0;
#pragma unroll
                for (int bj = 0; bj < 2; ++bj) { const u32x4 s = *(const u32x4*)(sg + off + bj * HALF);
                    const u32x4 tt = *(const u32x4*)(T1 + off + bj * HALF);
                    const f32x4 t0 = (f32x4){bf_lo(tt.x), bf_hi(tt.x), bf_lo(tt.y), bf_hi(tt.y)}, t1 = (f32x4){bf_lo(tt.z), bf_hi(tt.z), bf_lo(tt.w), bf_hi(tt.w)};
                    const f32x4 g0 = (f32x4){bf_lo(s.x), bf_hi(s.x), bf_lo(s.y), bf_hi(s.y)}, g1 = (f32x4){bf_lo(s.z), bf_hi(s.z), bf_lo(s.w), bf_hi(s.w)};
                    *(u32x4*)(MG + off + bj * HALF) = pack8(t0 + g0 * acc[ai][bj][m][0], t1 + g1 * acc[ai][bj][m][1]); }
                asm volatile("" ::: "memory"); }
    }
};
struct EpiF32P {
    static constexpr bool PERM = true, AFTER_DRAIN = false;
    bf16_t* C;
    __device__ __forceinline__ void operator()(const f32x4 (&acc)[2][2][4][2], const Unit& u, int wr, int wc, int fr, int fq) const {
        const int row0 = u.pm * BM + wr * 64 + fr, col0 = u.pn * BM + wc * 32 + 8 * fq;
#pragma unroll
        for (int ai = 0; ai < 2; ++ai)
#pragma unroll
            for (int m = 0; m < 4; ++m) { bf16_t* rowp = C + (size_t)(row0 + ai * HALF + m * 16) * 2048 + col0;
#pragma unroll
                for (int bj = 0; bj < 2; ++bj) *(u32x4*)(rowp + bj * HALF) = pack8(acc[ai][bj][m][0], acc[ai][bj][m][1]); }
    }
};
struct EpiPle {
    static constexpr bool PERM = true, AFTER_DRAIN = false;
    const float* PP; float* out; float alpha;
    __device__ __forceinline__ void operator()(const f32x4 (&acc)[2][2][4][2], const Unit& u, int wr, int wc, int fr, int fq) const {
        const int row0 = u.pm * BM + wr * 64 + fr, col0 = u.pn * BM + wc * 32 + 8 * fq;
#pragma unroll
        for (int ai = 0; ai < 2; ++ai)
#pragma unroll
            for (int m = 0; m < 4; ++m) { const size_t off = (size_t)(row0 + ai * HALF + m * 16) * 2048 + col0;
#pragma unroll
                for (int bj = 0; bj < 2; ++bj)
#pragma unroll
                    for (int n = 0; n < 2; ++n) { const f32x4 r = *(const f32x4*)(out + off + bj * HALF + 4 * n), p = *(const f32x4*)(PP + off + bj * HALF + 4 * n); f32x4 s;
#pragma unroll
                        for (int j = 0; j < 4; ++j) s[j] = sigm(acc[ai][bj][m][n][j]);
                        *(f32x4*)(out + off + bj * HALF + 4 * n) = r * alpha + s * p; }
                asm volatile("" ::: "memory"); }
    }
};

struct EpiResidLN {
    static constexpr bool PERM = true, AFTER_DRAIN = false;
    float* out; const f32x2* mr; const float* g; const float* b; float alpha, scale;
    __device__ __forceinline__ void operator()(const f32x4 (&acc)[2][2][4][2], const Unit& u, int wr, int wc, int fr, int fq) const {
        const int row0 = u.pm * BM + wr * 64 + fr, col0 = u.pn * BM + wc * 32 + 8 * fq;
#pragma unroll
        for (int ai = 0; ai < 2; ++ai)
#pragma unroll
            for (int m = 0; m < 4; ++m) { const int row = row0 + ai * HALF + m * 16; const size_t off = (size_t)row * 2048 + col0; const f32x2 s = mr[row];
#pragma unroll
                for (int bj = 0; bj < 2; ++bj)
#pragma unroll
                    for (int n = 0; n < 2; ++n) { const int c = col0 + bj * HALF + 4 * n; const f32x4 v = *(const f32x4*)(out + off + bj * HALF + 4 * n), gg = *(const f32x4*)(g + c), bb = *(const f32x4*)(b + c);
                        const f32x4 r = (v - s.x) * s.y * gg + bb; *(f32x4*)(out + off + bj * HALF + 4 * n) = r * alpha + acc[ai][bj][m][n] * scale; }
                asm volatile("" ::: "memory"); }
    }
};
struct EpiPleLN {
    static constexpr bool PERM = true, AFTER_DRAIN = false;
    const bf16_t* PP; float* out; const f32x2* mr; const float* g; const float* b; float alpha;
    __device__ __forceinline__ void operator()(const f32x4 (&acc)[2][2][4][2], const Unit& u, int wr, int wc, int fr, int fq) const {
        const int row0 = u.pm * BM + wr * 64 + fr, col0 = u.pn * BM + wc * 32 + 8 * fq;
#pragma unroll
        for (int ai = 0; ai < 2; ++ai)
#pragma unroll
            for (int m = 0; m < 4; ++m) { const int row = row0 + ai * HALF + m * 16; const size_t off = (size_t)row * 2048 + col0; const f32x2 s = mr[row];
#pragma unroll
                for (int bj = 0; bj < 2; ++bj) { const u32x4 pq = *(const u32x4*)(PP + off + bj * HALF);
#pragma unroll
                    for (int n = 0; n < 2; ++n) { const int c = col0 + bj * HALF + 4 * n; const f32x4 v = *(const f32x4*)(out + off + bj * HALF + 4 * n), p = n ? (f32x4){bf_lo(pq.z), bf_hi(pq.z), bf_lo(pq.w), bf_hi(pq.w)} : (f32x4){bf_lo(pq.x), bf_hi(pq.x), bf_lo(pq.y), bf_hi(pq.y)}, gg = *(const f32x4*)(g + c), bb = *(const f32x4*)(b + c); f32x4 sg;
#pragma unroll
                        for (int j = 0; j < 4; ++j) sg[j] = sigm(acc[ai][bj][m][n][j]);
                        const f32x4 r = (v - s.x) * s.y * gg + bb; *(f32x4*)(out + off + bj * HALF + 4 * n) = r * alpha + sg * p; } }
                asm volatile("" ::: "memory"); }
    }
};
template <class Epi, class Sched, bool ALIGN_EPI = false, bool SP2 = false>
__device__ __forceinline__ void gemm_phase(PG8_LAS unsigned char* lds, const Gemm g, const Sched& S, const Epi& E) {
    const int tid = threadIdx.x, wid = __builtin_amdgcn_readfirstlane(tid >> 6), lane = tid & 63, wr = wid >> 2, wc = wid & 3, fr = lane & 15, fq = lane >> 4;
    const int K = g.K, nt = K / BK;
    unsigned voffA[2], voffB[2];
#pragma unroll
    for (int i = 0; i < 2; ++i) { int R, C; stage_rc(tid * 16 + i * 8192, R, C); const int Rb = Epi::PERM ? ((R & ~31) + perm32(R & 31)) : R;
        voffA[i] = (unsigned)(R * K + C) * 2u; voffB[i] = (unsigned)(Rb * K + C) * 2u; }
    const size_t kstep = (size_t)(BK * 2);
    const size_t hstep = (size_t)HALF * K * 2;
    const size_t tstep = 2 * hstep;
    const unsigned ldsw = (unsigned)wid * 1024u;
    const int aoff = lds_byte(wr * 64 + fr, fq * 8), boff = lds_byte(wc * 32 + fr, fq * 8);
#define PG8_SA(b, h) (((b) * 2 + (h)) * HTB)
#define PG8_SB(b, h) ((4 + (b) * 2 + (h)) * HTB)
#define PG8_STAGE(bufoff, gbase, voff) do { _Pragma("unroll") for (int _i = 0; _i < 2; ++_i) \
        __builtin_amdgcn_global_load_lds((const unsigned*)((const char*)(gbase) + (voff)[_i]), (PG8_LAS unsigned*)(lds + (bufoff) + ldsw + _i * 8192), 16, 0, 0); } while (0)
#define PG8_LDA(dst, b, h) do { _Pragma("unroll") for (int m = 0; m < 4; ++m) _Pragma("unroll") for (int k = 0; k < 2; ++k) dst[m][k] = *(const PG8_LAS bf16x8*)(lds + PG8_SA(b, h) + aoff + m * 2048 + k * 1024); } while (0)
#define PG8_LDB(dst, b, h) do { _Pragma("unroll") for (int n = 0; n < 2; ++n) _Pragma("unroll") for (int k = 0; k < 2; ++k) dst[n][k] = *(const PG8_LAS bf16x8*)(lds + PG8_SB(b, h) + boff + n * 2048 + k * 1024); } while (0)
#define PG8_MMA(ai, bj, At, Bt) do { __builtin_amdgcn_s_setprio(1); _Pragma("unroll") for (int m = 0; m < 4; ++m) _Pragma("unroll") for (int n = 0; n < 2; ++n) _Pragma("unroll") for (int k = 0; k < 2; ++k) \
        acc[ai][bj][m][n] = __builtin_amdgcn_mfma_f32_16x16x32_bf16(Bt[n][k], At[m][k], acc[ai][bj][m][n], 0, 0, 0); __builtin_amdgcn_s_setprio(0); } while (0)
#define PG8_WAIT_V(n) asm volatile("s_waitcnt vmcnt(" #n ")" ::: "memory")
#define PG8_WAIT_L(n) asm volatile("s_waitcnt lgkmcnt(" #n ")" ::: "memory")
#define PG8_BAR __builtin_amdgcn_s_barrier()
#define PG8_SCHED __builtin_amdgcn_sched_barrier(0)
    Unit cur, nxt; int ui = 0;
    if (!S.next(0, cur)) return;
    f32x4 acc[2][2][4][2];
#pragma unroll
    for (int a = 0; a < 2; ++a)
#pragma unroll
        for (int b = 0; b < 2; ++b)
#pragma unroll
            for (int m = 0; m < 4; ++m)
#pragma unroll
                for (int n = 0; n < 2; ++n) acc[a][b][m][n] = (f32x4){0.f, 0.f, 0.f, 0.f};
    bf16x8 At[4][2], B0[2][2], B1[2][2];
    const char* cA = (const char*)g.A + (size_t)cur.pm * tstep; const char* cB = (const char*)g.Bt + (size_t)cur.pn * tstep;
    S.a_ready(cur);
    if constexpr (SP2) {
        PG8_STAGE(PG8_SB(0, 0), cB, voffB); PG8_STAGE(PG8_SB(0, 1), cB + hstep, voffB); PG8_STAGE(PG8_SA(0, 0), cA, voffA); PG8_STAGE(PG8_SA(0, 1), cA + hstep, voffA);
        if (wr == 1) PG8_BAR;
        PG8_WAIT_V(2); PG8_BAR;
        PG8_STAGE(PG8_SB(1, 0), cB + kstep, voffB); PG8_STAGE(PG8_SA(1, 0), cA + kstep, voffA); PG8_STAGE(PG8_SB(1, 1), cB + hstep + kstep, voffB);
        PG8_WAIT_V(6); PG8_BAR;
    } else {
        PG8_STAGE(PG8_SB(0, 0), cB, voffB); PG8_STAGE(PG8_SA(0, 0), cA, voffA); PG8_STAGE(PG8_SB(0, 1), cB + hstep, voffB); PG8_STAGE(PG8_SA(0, 1), cA + hstep, voffA);
        if (wr == 1) PG8_BAR;
        PG8_WAIT_V(4); PG8_BAR;
        PG8_STAGE(PG8_SB(1, 0), cB + kstep, voffB); PG8_STAGE(PG8_SA(1, 0), cA + kstep, voffA); PG8_STAGE(PG8_SB(1, 1), cB + hstep + kstep, voffB);
        PG8_WAIT_V(6); PG8_BAR;
    }
    for (;;) {
        const bool has_next = S.next(ui + 1, nxt);
        const char* nA = has_next ? (const char*)g.A + (size_t)nxt.pm * tstep : cA; const char* nB = has_next ? (const char*)g.Bt + (size_t)nxt.pn * tstep : cB;
        for (int t = 0; t < nt; t += 2) {
            const bool last = (t == nt - 2);
            const char* a1 = cA + (size_t)(t + 1) * kstep;
            const char* a2 = last ? nA : cA + (size_t)(t + 2) * kstep; const char* b2 = last ? nB : cB + (size_t)(t + 2) * kstep;
            const char* a3 = a2 + kstep; const char* b3 = b2 + kstep;
            if (last && has_next) S.a_ready(nxt);
            if constexpr (SP2) {
            PG8_LDB(B0, 0, 0); PG8_LDB(B1, 0, 1); PG8_SCHED; PG8_LDA(At, 0, 0); PG8_STAGE(PG8_SA(1, 1), a1 + hstep, voffA);
            PG8_WAIT_V(8); PG8_WAIT_L(0); PG8_BAR; PG8_MMA(0, 0, At, B0); PG8_MMA(0, 1, At, B1); PG8_BAR; PG8_SCHED;
            PG8_LDA(At, 0, 1); PG8_STAGE(PG8_SB(0, 0), b2, voffB); PG8_STAGE(PG8_SB(0, 1), b2 + hstep, voffB); PG8_STAGE(PG8_SA(0, 0), a2, voffA);
            PG8_WAIT_V(8); PG8_WAIT_L(0); PG8_BAR; PG8_MMA(1, 0, At, B0); PG8_MMA(1, 1, At, B1); PG8_BAR; PG8_SCHED;
            PG8_LDB(B0, 1, 0); PG8_LDB(B1, 1, 1); PG8_SCHED; PG8_LDA(At, 1, 0); PG8_STAGE(PG8_SA(0, 1), a2 + hstep, voffA);
            PG8_WAIT_V(8); PG8_WAIT_L(0); PG8_BAR; PG8_MMA(0, 0, At, B0); PG8_MMA(0, 1, At, B1); PG8_BAR; PG8_SCHED;
            PG8_LDA(At, 1, 1); PG8_STAGE(PG8_SB(1, 0), b3, voffB); PG8_STAGE(PG8_SB(1, 1), b3 + hstep, voffB); PG8_STAGE(PG8_SA(1, 0), a3, voffA);
            PG8_WAIT_V(8); PG8_WAIT_L(0); PG8_BAR; PG8_MMA(1, 0, At, B0); PG8_MMA(1, 1, At, B1); PG8_BAR; PG8_SCHED;
            } else {
            PG8_LDB(B0, 0, 0); PG8_SCHED; PG8_LDA(At, 0, 0); PG8_STAGE(PG8_SA(1, 1), a1 + hstep, voffA);
            PG8_WAIT_L(8); PG8_BAR; PG8_WAIT_L(0); PG8_MMA(0, 0, At, B0); PG8_BAR; PG8_SCHED;
            PG8_LDB(B1, 0, 1); PG8_STAGE(PG8_SB(0, 0), b2, voffB);
            PG8_BAR; PG8_WAIT_L(0); PG8_MMA(0, 1, At, B1); PG8_BAR;
            PG8_LDA(At, 0, 1); PG8_STAGE(PG8_SA(0, 0), a2, voffA);
            PG8_BAR; PG8_WAIT_L(0); PG8_MMA(1, 0, At, B0); PG8_BAR; PG8_SCHED;
            PG8_STAGE(PG8_SB(0, 1), b2 + hstep, voffB);
            PG8_WAIT_V(6); PG8_BAR; PG8_MMA(1, 1, At, B1); PG8_BAR;
            PG8_LDB(B0, 1, 0); PG8_SCHED; PG8_LDA(At, 1, 0); PG8_STAGE(PG8_SA(0, 1), a2 + hstep, voffA);
            PG8_WAIT_L(8); PG8_BAR; PG8_WAIT_L(0); PG8_MMA(0, 0, At, B0); PG8_BAR; PG8_SCHED;
            PG8_LDB(B1, 1, 1); PG8_STAGE(PG8_SB(1, 0), b3, voffB);
            PG8_BAR; PG8_WAIT_L(0); PG8_MMA(0, 1, At, B1); PG8_BAR;
            PG8_LDA(At, 1, 1); PG8_STAGE(PG8_SA(1, 0), a3, voffA);
            PG8_BAR; PG8_WAIT_L(0); PG8_MMA(1, 0, At, B0); PG8_BAR; PG8_SCHED;
            PG8_STAGE(PG8_SB(1, 1), b3 + hstep, voffB);
            PG8_WAIT_V(6); PG8_BAR; PG8_MMA(1, 1, At, B1); PG8_BAR;
            }
        }
        if constexpr (ALIGN_EPI) { if (wr == 0) PG8_BAR; }
        if constexpr (!Epi::AFTER_DRAIN) { E(acc, cur, wr, wc, fr, fq); S.done(cur); }
        if (!has_next) break;
#pragma unroll
        for (int a = 0; a < 2; ++a)
#pragma unroll
            for (int b = 0; b < 2; ++b)
#pragma unroll
                for (int m = 0; m < 4; ++m)
#pragma unroll
                    for (int n = 0; n < 2; ++n) acc[a][b][m][n] = (f32x4){0.f, 0.f, 0.f, 0.f};
        cur = nxt; cA = nA; cB = nB; ++ui;
        if constexpr (ALIGN_EPI) { if (wr == 1) PG8_BAR; }
    }
    PG8_WAIT_V(0);
    if constexpr (!ALIGN_EPI) { if (wr == 0) PG8_BAR; }
    PG8_BAR;
    if constexpr (Epi::AFTER_DRAIN) { E.fused(acc, cur, wr, wc, fr, fq, lds, wid, lane); S.done(cur); }
#undef PG8_SA
#undef PG8_SB
#undef PG8_STAGE
#undef PG8_LDA
#undef PG8_LDB
#undef PG8_MMA
#undef PG8_WAIT_V
#undef PG8_WAIT_L
#undef PG8_BAR
#undef PG8_SCHED
}
}

#ifndef MK_N_LAUNCHES
#define MK_N_LAUNCHES 1
#endif
constexpr int M = 16384, D = 2048, FF = 5504, NMIX = 11264, CW = 1024, PLE = 256, SEQ = 4096, NHEAD = 8;
constexpr float LN_EPS = 1e-5f, RMS_EPS = 1e-6f;
constexpr float ALPHA = 1.18920711500272f;
constexpr int NWAVES = 8, NTHREADS = 512;
constexpr size_t HMiB = 1u << 19;
constexpr size_t WS_XN = 2 * HMiB;
constexpr size_t WS_W1IN = 130 * HMiB, WS_W1OUT = 216 * HMiB, WS_WMIX = 259 * HMiB, WS_WA = 347 * HMiB, WS_WB = 355 * HMiB, WS_WMO = 363 * HMiB, WS_WPG = 379 * HMiB, WS_WPP = 395 * HMiB;
constexpr size_t WS_PB = 397 * HMiB;
constexpr size_t WS_DEC = 413 * HMiB;
constexpr size_t WS_BIG = 414 * HMiB;
constexpr size_t WS_H = WS_BIG;
constexpr size_t WS_Z = WS_BIG;
constexpr size_t ZSZ = (size_t)M * 1024;
constexpr size_t WS_T1 = WS_BIG + 128 * HMiB;
constexpr size_t WS_W2IN = WS_BIG + 344 * HMiB, WS_W2OUT = WS_W2IN + 86 * HMiB;
constexpr size_t WS_PP = WS_BIG;
constexpr size_t WS_END = WS_BIG + 640 * HMiB;
static_assert(WS_W1IN + (size_t)2 * FF * D * 2 == WS_W1OUT && WS_W1OUT + (size_t)D * FF * 2 == WS_WMIX && WS_WMIX + (size_t)NMIX * D * 2 == WS_WA, "ws map 1");
static_assert(WS_WB + (size_t)D * CW * 2 == WS_WMO && WS_WMO + (size_t)D * D * 2 == WS_WPG && WS_WPP + (size_t)D * PLE * 2 == WS_PB && WS_PB + (size_t)M * PLE * 2 == WS_DEC, "ws map 2");
static_assert(WS_H + (size_t)M * FF * 2 == WS_W2IN && WS_W2OUT + (size_t)D * FF * 2 <= WS_END && WS_Z + 10 * ZSZ * 2 == WS_END && WS_XN + (size_t)M * D * 2 == WS_W1IN, "ws map 3");

#define LAS __attribute__((address_space(3)))
typedef unsigned short bf16;
typedef unsigned v4u __attribute__((ext_vector_type(4)));
typedef unsigned v2u __attribute__((ext_vector_type(2)));
typedef float f32x4 __attribute__((ext_vector_type(4)));
typedef short bf16x8 __attribute__((ext_vector_type(8)));
constexpr int MISC_OFF = 143360, LDS_BYTES = MISC_OFF + 1024;
#define LDS_WAIT() asm volatile("s_waitcnt lgkmcnt(0)" ::: "memory")
#define LDS_BARRIER() do { asm volatile("s_waitcnt lgkmcnt(0)" ::: "memory"); __builtin_amdgcn_s_barrier(); asm volatile("" ::: "memory"); } while (0)
__device__ __forceinline__ unsigned pk2(float lo, float hi) { return pg8::cvt_pk_bf16(lo, hi); }
__device__ __forceinline__ float bf2f(bf16 v) { return __uint_as_float(((unsigned)v) << 16); }
__device__ __forceinline__ float wave_sum(float v) {
#pragma unroll
    for (int o = 1; o < 64; o <<= 1) v += __shfl_xor(v, o);
    return v;
}
__device__ __forceinline__ float fexp(float x) { return __builtin_amdgcn_exp2f(1.4426950408889634f * x); }

__device__ __forceinline__ int map_col(int kind, int n0) {
    if (kind == 0) return n0;
    const int tile = n0 >> 8, i = n0 & 255;
    if (kind == 1) return (i < 128) ? (tile * 128 + i) : (FF + tile * 128 + (i - 128));
    if (tile >= 4 && tile < 12) { const int q = tile - 4; return (i < 128) ? (1024 + q * 128 + i) : (2048 + q * 128 + (i - 128)); }
    return n0;
}
struct TJob { const float* W; bf16* WT; int K, N, k0, n0, sc; };
__device__ __forceinline__ TJob tjob(const float* W, int K, int N, bf16* WT, int kind, int item) {
    const int nblk = N / 32, kb = item / nblk, nb = item % nblk; TJob j; j.W = W; j.WT = WT; j.K = K; j.N = N; j.k0 = 64 * kb; j.n0 = 32 * nb; j.sc = map_col(kind, j.n0); return j; }
#define TJ_LOAD(tv, j, lane) do { _Pragma("unroll") for (int i_ = 0; i_ < 32; ++i_) (tv)[i_] = __builtin_nontemporal_load((j).W + (size_t)((j).k0 + 2 * i_ + ((lane) >> 5)) * (j).N + (j).sc + ((lane) & 31)); } while (0)
__device__ __forceinline__ void tjob_finish(const TJob& j, const float (&tv)[32], LAS float* scr, int lane) {
#pragma unroll
    for (int i = 0; i < 32; ++i) scr[(2 * i + (lane >> 5)) * 33 + (lane & 31)] = tv[i];
    LDS_WAIT(); asm volatile("" ::: "memory");
    const int c = lane & 7;
#pragma unroll
    for (int jj = 0; jj < 4; ++jj) { const int n = (lane >> 3) + 8 * jj; const LAS float* s = scr + (8 * c) * 33 + n;
        v4u o; o.x = pk2(s[0 * 33], s[1 * 33]); o.y = pk2(s[2 * 33], s[3 * 33]); o.z = pk2(s[4 * 33], s[5 * 33]); o.w = pk2(s[6 * 33], s[7 * 33]);
        *(v4u*)(j.WT + (size_t)(j.n0 + n) * j.K + j.k0 + 8 * c) = o; }
    LDS_WAIT(); asm volatile("" ::: "memory");
}
__device__ __forceinline__ void cvt_copy(const float* src, bf16* dst, size_t n, size_t gt, size_t ngt) {
    size_t i = gt * 8;
    for (; i + 3 * ngt * 8 < n; i += 4 * ngt * 8) { f32x4 a[4], b[4];
#pragma unroll
        for (int u = 0; u < 4; ++u) { a[u] = *(const f32x4*)(src + i + u * ngt * 8); b[u] = *(const f32x4*)(src + i + u * ngt * 8 + 4); }
#pragma unroll
        for (int u = 0; u < 4; ++u) { v4u o; o.x = pk2(a[u][0], a[u][1]); o.y = pk2(a[u][2], a[u][3]); o.z = pk2(b[u][0], b[u][1]); o.w = pk2(b[u][2], b[u][3]); *(v4u*)(dst + i + u * ngt * 8) = o; } }
    for (; i < n; i += ngt * 8) { const f32x4 a = *(const f32x4*)(src + i), b = *(const f32x4*)(src + i + 4);
        v4u o; o.x = pk2(a[0], a[1]); o.y = pk2(a[2], a[3]); o.z = pk2(b[0], b[1]); o.w = pk2(b[2], b[3]); *(v4u*)(dst + i) = o; }
}
__device__ __forceinline__ void ln_pass(float* X, bf16* XN, pg8::f32x2* MR, const float* g, const float* b, int gw, int ngw, int lane, int row_end = M) {
    for (int row = gw; row < row_end; row += ngw) {
        f32x4* xr = (f32x4*)(X + (size_t)row * D) + lane;
        f32x4 v[8]; float s = 0.f;
#pragma unroll
        for (int j = 0; j < 8; ++j) { v[j] = xr[64 * j]; s += (v[j][0] + v[j][1]) + (v[j][2] + v[j][3]); }
        const float mean = wave_sum(s) * (1.f / D); float s2 = 0.f;
#pragma unroll
        for (int j = 0; j < 8; ++j) { v[j] = v[j] - mean; s2 += (v[j][0] * v[j][0] + v[j][1] * v[j][1]) + (v[j][2] * v[j][2] + v[j][3] * v[j][3]); }
        const float rstd = 1.f / sqrtf(wave_sum(s2) * (1.f / D) + LN_EPS);
#pragma unroll
        for (int j = 0; j < 8; ++j) { const f32x4 gg = ((const f32x4*)g)[lane + 64 * j], bb = ((const f32x4*)b)[lane + 64 * j]; const f32x4 y = v[j] * rstd * gg + bb;
            if (!MR) xr[64 * j] = y;
            if (XN) { v2u o; o.x = pk2(y[0], y[1]); o.y = pk2(y[2], y[3]); *(v2u*)(XN + (size_t)row * D + (size_t)(lane + 64 * j) * 4) = o; } }
        if (MR && lane == 0) MR[row] = (pg8::f32x2){mean, rstd};
    }
}
__device__ __forceinline__ void conv_pass(bf16* BB, const bf16* CH, const float* cw, int gt, int ngt, int gi_end = (M / 16) * 128) {
    for (int gi = gt; gi < gi_end; gi += ngt) {
        const int rg = gi >> 7, ch = gi & 127, r0 = rg * 16, c0 = ch * 8;
        float w0[8], w1[8], w2[8], p1[8], p2[8];
#pragma unroll
        for (int e = 0; e < 8; ++e) { w0[e] = cw[c0 + e]; w1[e] = cw[1024 + c0 + e]; w2[e] = cw[2048 + c0 + e]; p1[e] = 0.f; p2[e] = 0.f; }
        if ((r0 & (SEQ - 1)) != 0) { const v4u a = *(const v4u*)(CH + (size_t)(r0 - 2) * 1024 + c0), b = *(const v4u*)(CH + (size_t)(r0 - 1) * 1024 + c0);
#pragma unroll
            for (int e = 0; e < 4; ++e) { p2[2 * e] = pg8::bf_lo(a[e]); p2[2 * e + 1] = pg8::bf_hi(a[e]); p1[2 * e] = pg8::bf_lo(b[e]); p1[2 * e + 1] = pg8::bf_hi(b[e]); } }
#pragma unroll 4
        for (int r = 0; r < 16; ++r) { const size_t off = (size_t)(r0 + r) * 1024 + c0; const v4u cc = *(const v4u*)(CH + off), bv = *(const v4u*)(BB + off); float cu[8], y[8];
#pragma unroll
            for (int e = 0; e < 4; ++e) { cu[2 * e] = pg8::bf_lo(cc[e]); cu[2 * e + 1] = pg8::bf_hi(cc[e]); y[2 * e] = pg8::bf_lo(bv[e]); y[2 * e + 1] = pg8::bf_hi(bv[e]); }
#pragma unroll
            for (int e = 0; e < 8; ++e) { y[e] *= (w0[e] * p2[e] + w1[e] * p1[e] + w2[e] * cu[e]); p2[e] = p1[e]; p1[e] = cu[e]; }
            v4u o; o.x = pk2(y[0], y[1]); o.y = pk2(y[2], y[3]); o.z = pk2(y[4], y[5]); o.w = pk2(y[6], y[7]); *(v4u*)(BB + off) = o; }
    }
}

#define XB_TMO      128
#define XB_XCNT(j)  (256  + 64 * (j))
#define XB_XSUB(j)  (1280 + 64 * (j))
#define XB_XGEN(j)  (2304 + 64 * (j))
#define XB_TOP      3328
#define XB_TOPGEN   3392
#define XCD_BAR_WORDS 3456
#define XB_SPIN_CAP (1u << 18)

__device__ __forceinline__ unsigned xb_ld(unsigned* p)              { return __hip_atomic_load(p, __ATOMIC_RELAXED, __HIP_MEMORY_SCOPE_AGENT); }
__device__ __forceinline__ unsigned xb_add(unsigned* p, unsigned v) { return __hip_atomic_fetch_add(p, v, __ATOMIC_RELAXED, __HIP_MEMORY_SCOPE_AGENT); }
__device__ __forceinline__ unsigned xb_xcc_id() { return (unsigned)__builtin_amdgcn_s_getreg((3 << 11) | 20) & 0xFu; }
#define XB_SPIN(cond, bar) do { unsigned _sp = 0; while (cond) { __builtin_amdgcn_s_sleep(1); \
    if ((++_sp & 255u) == 0u) { if (xb_ld(&(bar)[XB_TMO])) break; if (_sp > XB_SPIN_CAP) { atomicAdd(&(bar)[XB_TMO], 1u); break; } } } } while (0)

struct XcdBarrier {
    unsigned* bar; unsigned x;
    volatile LAS unsigned* st;
};

__device__ __forceinline__ XcdBarrier xcd_barrier_post(unsigned* bar, volatile LAS unsigned* st) {
    XcdBarrier b; b.bar = bar; b.x = xb_xcc_id(); b.st = st;
    if (threadIdx.x == 0) (void)xb_add(&bar[XB_XCNT(b.x)], 1u);
    return b;
}
__device__ __forceinline__ void xcd_barrier_complete(unsigned* bar, unsigned x, unsigned& nloc, unsigned& nx) {
    const unsigned G = gridDim.x * gridDim.y * gridDim.z;
    unsigned sum, cnt, mine, sp = 0u;
    for (;;) {
        sum = 0u; cnt = 0u; mine = 0u;
#pragma unroll
        for (unsigned j = 0; j < 16; ++j) { const unsigned c = xb_ld(&bar[XB_XCNT(j)]); sum += c; cnt += (c > 0u) ? 1u : 0u; mine = (j == x) ? c : mine; }
        if (sum == G) break;
        __builtin_amdgcn_s_sleep(1);
        if ((++sp & 255u) == 0u) { if (xb_ld(&bar[XB_TMO])) break; if (sp > XB_SPIN_CAP) { atomicAdd(&bar[XB_TMO], 1u); break; } }
    }
    nloc = mine > 0u ? mine : 1u; nx = cnt > 0u ? cnt : 1u;
}

__device__ __forceinline__ void xcd_barrier(const XcdBarrier& b) {
    asm volatile("s_waitcnt vmcnt(0)" ::: "memory");
    __syncthreads();
    if (threadIdx.x == 0) {
        unsigned* bar = b.bar;
        __builtin_amdgcn_s_waitcnt(0);
        unsigned nloc = b.st[0], nx = b.st[1];
        if (nloc == 0u) { xcd_barrier_complete(bar, b.x, nloc, nx); b.st[0] = nloc; b.st[1] = nx; }
        const unsigned old = xb_add(&bar[XB_XSUB(b.x)], 1u);
        const unsigned gen = old / nloc;
        if (old + 1u == (gen + 1u) * nloc) {
            __builtin_amdgcn_fence(__ATOMIC_RELEASE, "agent");
            asm volatile("s_waitcnt vmcnt(0)" ::: "memory");
            const unsigned og = xb_add(&bar[XB_TOP], 1u);
            const unsigned tg = og / nx;
            if (og + 1u == (tg + 1u) * nx) xb_add(&bar[XB_TOPGEN], 1u);
            else XB_SPIN(xb_ld(&bar[XB_TOPGEN]) == tg, bar);
            __builtin_amdgcn_fence(__ATOMIC_ACQUIRE, "agent");
            xb_add(&bar[XB_XGEN(b.x)], 1u);
            asm volatile("s_waitcnt vmcnt(0)" ::: "memory");
        } else {
            XB_SPIN(xb_ld(&bar[XB_XGEN(b.x)]) == gen, bar);
            __builtin_amdgcn_fence(__ATOMIC_ACQUIRE, "agent");
            asm volatile("s_waitcnt vmcnt(0)" ::: "memory");
        }
    }
    __syncthreads();
}

struct HgPtrs { const bf16 *QB, *FB, *VB, *GB; bf16* YB; float* ST; float* DEC; const float* hlb; const float* nw; };
constexpr int HL_QR = 0, HL_FR = 8192, HL_GR = 16384, HL_VT = 24576, HL_QS = 34816, HL_KS = 43520, HL_KT = 52224, HL_SVT = 62464, HL_PS = 97280, HL_TOT = 99840, HL_EL = 101888, HL_SSQ = 102400, HL_OS = 103424;
template <int MODE> __device__ __forceinline__ void hgrn_phase(LAS unsigned char* lds, const HgPtrs& P, int first, int step, int tid, int last = 1024) {
    const int lt0 = tid >> 4, lc0 = tid & 15;
    v4u rf, rv, rq = (v4u){0u, 0u, 0u, 0u}, rg = (v4u){0u, 0u, 0u, 0u};
#define HG_LOAD(it_, sc_) do { const int bh_ = (it_) >> 5, j_ = (it_) & 31; const size_t go_ = (size_t)((bh_ >> 3) * SEQ + j_ * 128 + (sc_) * 32 + lt0) * 1024 + (bh_ & 7) * 128 + lc0 * 8; \
        rf = *(const v4u*)(P.FB + go_); rv = *(const v4u*)(P.VB + (size_t)((bh_ >> 3) * SEQ + j_ * 128 + (sc_) * 32 + (tid & 31)) * 1024 + (bh_ & 7) * 128 + (tid >> 5) * 8); if (MODE == 1) { rq = *(const v4u*)(P.QB + go_); rg = *(const v4u*)(P.GB + go_); } } while (0)
    if (first < last) HG_LOAD(first, 0);
  for (int item = first; item < last; item += step) {
    const int bh = item >> 5, j = item & 31, b = bh >> 3, h = bh & 7;
    const int row0 = b * SEQ + j * 128, col0 = h * 128;
    const int lane = tid & 63, w = __builtin_amdgcn_readfirstlane(tid >> 6), li = lane & 15, lg = lane >> 4;
    const int lt = tid >> 4, lc = tid & 15;
    const int pk = tid & 127, tq = tid >> 7;
    LAS bf16* QR = (LAS bf16*)(lds + HL_QR); LAS bf16* FR = (LAS bf16*)(lds + HL_FR); LAS bf16* GR = (LAS bf16*)(lds + HL_GR);
    LAS bf16* VT = (LAS bf16*)(lds + HL_VT); LAS bf16* QS = (LAS bf16*)(lds + HL_QS); LAS bf16* KS = (LAS bf16*)(lds + HL_KS);
    LAS bf16* KT = (LAS bf16*)(lds + HL_KT); LAS bf16* SVT = (LAS bf16*)(lds + HL_SVT); LAS bf16* PS = (LAS bf16*)(lds + HL_PS);
    LAS float* TOT = (LAS float*)(lds + HL_TOT); LAS float* EL = (LAS float*)(lds + HL_EL); LAS float* SSQ = (LAS float*)(lds + HL_SSQ); LAS bf16* OS = (LAS bf16*)(lds + HL_OS);
    const float oml = 1.f - 1.f / (1.f + fexp(P.hlb[1024 + col0 + pk] - P.hlb[col0 + pk]));
    float dtot = 1.f;
    f32x4 accS[8];
    float* stp = P.ST + (size_t)item * 16384 + (size_t)(16 * w + 4 * lg) * 128 + li;
#pragma unroll
    for (int vb = 0; vb < 8; ++vb) {
        if (MODE == 1) {
#pragma unroll
            for (int jj = 0; jj < 4; ++jj) accS[vb][jj] = stp[jj * 128 + 16 * vb];
            v2u o; o.x = pk2(accS[vb][0], accS[vb][1]); o.y = pk2(accS[vb][2], accS[vb][3]);
            *(LAS v2u*)(SVT + (16 * vb + li) * 136 + 16 * w + 4 * lg) = o;
        } else accS[vb] = (f32x4){0.f, 0.f, 0.f, 0.f};
    }
    for (int sc = 0; sc < 4; ++sc) {
        { const v4u vv = rv;
          *(LAS v4u*)(FR + lt * 128 + lc * 8) = rf;
#pragma unroll
          for (int e = 0; e < 4; ++e) { VT[((tid >> 5) * 8 + 2 * e) * 40 + (tid & 31)] = (bf16)(vv[e] & 0xffffu); VT[((tid >> 5) * 8 + 2 * e + 1) * 40 + (tid & 31)] = (bf16)(vv[e] >> 16); }
          if (MODE == 1) { *(LAS v4u*)(QR + lt * 128 + lc * 8) = rq; *(LAS v4u*)(GR + lt * 128 + lc * 8) = rg; }
          if (sc < 3) HG_LOAD(item, sc + 1); else if (item + step < last) HG_LOAD(item + step, 0); }
        LDS_BARRIER();
        float kk[8], cs[8]; float run = 0.f;
#pragma unroll
        for (int e = 0; e < 8; ++e) { const float fr = bf2f(FR[(8 * tq + e) * 128 + pk]); kk[e] = oml * __builtin_amdgcn_rcpf(1.f + fexp(fr)); run += __logf(1.f - kk[e]); cs[e] = run; }
        TOT[tq * 128 + pk] = run;
        LDS_BARRIER();
        { const float t0 = TOT[pk], t1 = TOT[128 + pk], t2 = TOT[256 + pk], t3 = TOT[384 + pk];
          const float pre = (tq > 0 ? t0 : 0.f) + (tq > 1 ? t1 : 0.f) + (tq > 2 ? t2 : 0.f), last = (t0 + t1) + (t2 + t3);
          float kt[8];
          const float elast = fexp(last);
#pragma unroll
          for (int e = 0; e < 8; ++e) { const float cum = pre + cs[e];
              if (MODE == 1) { const int t = 8 * tq + e; const float qr = bf2f(QR[t * 128 + pk]); const float kn = kk[e] * fexp(-cum); kt[e] = kn * elast;
                  QS[t * 136 + pk] = (bf16)(pk2(qr * pg8::sigm(qr) * fexp(cum), 0.f) & 0xffffu); KS[t * 136 + pk] = (bf16)(pk2(kn, 0.f) & 0xffffu); }
              else kt[e] = kk[e] * fexp(last - cum); }
          v4u o; o.x = pk2(kt[0], kt[1]); o.y = pk2(kt[2], kt[3]); o.z = pk2(kt[4], kt[5]); o.w = pk2(kt[6], kt[7]);
          *(LAS v4u*)(KT + pk * 40 + 8 * tq) = o;
          if (tq == 0) { EL[pk] = elast; dtot *= elast; } }
        LDS_BARRIER();
        f32x4 accO[2];
        if (MODE == 1) {
#pragma unroll
            for (int tb = 0; tb < 2; ++tb) { accO[tb] = (f32x4){0.f, 0.f, 0.f, 0.f};
#pragma unroll
                for (int kb = 0; kb < 4; ++kb) { const bf16x8 a = *(const LAS bf16x8*)(QS + (16 * tb + li) * 136 + 32 * kb + 8 * lg), bb = *(const LAS bf16x8*)(SVT + (16 * w + li) * 136 + 32 * kb + 8 * lg);
                    accO[tb] = __builtin_amdgcn_mfma_f32_16x16x32_bf16(a, bb, accO[tb], 0, 0, 0); } }
            if (w < 4) { const int tb = w >> 1, sb = w & 1; f32x4 sa = (f32x4){0.f, 0.f, 0.f, 0.f};
#pragma unroll
                for (int kb = 0; kb < 4; ++kb) { const bf16x8 a = *(const LAS bf16x8*)(QS + (16 * tb + li) * 136 + 32 * kb + 8 * lg), bb = *(const LAS bf16x8*)(KS + (16 * sb + li) * 136 + 32 * kb + 8 * lg);
                    sa = __builtin_amdgcn_mfma_f32_16x16x32_bf16(a, bb, sa, 0, 0, 0); }
#pragma unroll
                for (int jj = 0; jj < 4; ++jj) { const int t = 16 * tb + 4 * lg + jj, s = 16 * sb + li; PS[t * 40 + s] = (bf16)(pk2(s <= t ? sa[jj] : 0.f, 0.f) & 0xffffu); } }
            LDS_BARRIER();
#pragma unroll
            for (int tb = 0; tb < 2; ++tb) { const bf16x8 a = *(const LAS bf16x8*)(PS + (16 * tb + li) * 40 + 8 * lg), bb = *(const LAS bf16x8*)(VT + (16 * w + li) * 40 + 8 * lg);
                accO[tb] = __builtin_amdgcn_mfma_f32_16x16x32_bf16(a, bb, accO[tb], 0, 0, 0); }
        }
        { const bf16x8 a = *(const LAS bf16x8*)(KT + (16 * w + li) * 40 + 8 * lg); const f32x4 el = *(const LAS f32x4*)(EL + 16 * w + 4 * lg);
#pragma unroll
          for (int vb = 0; vb < 8; ++vb) { const bf16x8 bb = *(const LAS bf16x8*)(VT + (16 * vb + li) * 40 + 8 * lg);
              accS[vb] = __builtin_amdgcn_mfma_f32_16x16x32_bf16(a, bb, accS[vb] * el, 0, 0, 0);
              if (MODE == 1 && sc < 3) { v2u o; o.x = pk2(accS[vb][0], accS[vb][1]); o.y = pk2(accS[vb][2], accS[vb][3]); *(LAS v2u*)(SVT + (16 * vb + li) * 136 + 16 * w + 4 * lg) = o; } } }
        if (MODE == 1) {
#pragma unroll
            for (int tb = 0; tb < 2; ++tb)
#pragma unroll
                for (int jj = 0; jj < 4; ++jj) { float s2 = accO[tb][jj] * accO[tb][jj]; s2 += __shfl_xor(s2, 1); s2 += __shfl_xor(s2, 2); s2 += __shfl_xor(s2, 4); s2 += __shfl_xor(s2, 8);
                    if (li == 0) SSQ[(16 * tb + 4 * lg + jj) * 8 + w] = s2; }
            LDS_BARRIER();
            const float nwv = P.nw[16 * w + li];
#pragma unroll
            for (int tb = 0; tb < 2; ++tb)
#pragma unroll
                for (int jj = 0; jj < 4; ++jj) { const int t = 16 * tb + 4 * lg + jj; const f32x4 q0 = *(const LAS f32x4*)(SSQ + t * 8), q1 = *(const LAS f32x4*)(SSQ + t * 8 + 4);
                    const float ss = ((q0[0] + q0[1]) + (q0[2] + q0[3])) + ((q1[0] + q1[1]) + (q1[2] + q1[3]));
                    const float rstd = __builtin_amdgcn_rsqf(ss * (1.f / 128.f) + RMS_EPS); const float gr = bf2f(GR[t * 128 + 16 * w + li]);
                    OS[t * 128 + 16 * w + li] = (bf16)(pk2(accO[tb][jj] * rstd * nwv * gr * pg8::sigm(gr), 0.f) & 0xffffu); }
            LDS_BARRIER();
            *(v4u*)(P.YB + (size_t)(row0 + sc * 32 + lt) * 1024 + col0 + lc * 8) = *(const LAS v4u*)(OS + lt * 128 + lc * 8);
        } else {
            LDS_BARRIER();
        }
    }
    if (MODE == 0) {
#pragma unroll
        for (int vb = 0; vb < 8; ++vb)
#pragma unroll
            for (int jj = 0; jj < 4; ++jj) stp[jj * 128 + 16 * vb] = accS[vb][jj];
        if (tq == 0) P.DEC[(size_t)item * 128 + pk] = dtot;
    }
    LDS_BARRIER();
  }
#undef HG_LOAD
}

constexpr int H1_FR = 0, H1_VT = 32768, H1_KT = 67584, H1_TOT = 102400;
__device__ __forceinline__ void hgrn_pass1(LAS unsigned char* lds, const HgPtrs& P, int first, int step, int last, int tid) {
    LAS bf16* FRB = (LAS bf16*)(lds + H1_FR); LAS bf16* VT2 = (LAS bf16*)(lds + H1_VT); LAS bf16* KT2 = (LAS bf16*)(lds + H1_KT); LAS float* TOT2 = (LAS float*)(lds + H1_TOT);
    const int lane = tid & 63, w = __builtin_amdgcn_readfirstlane(tid >> 6), li = lane & 15, lg = lane >> 4;
    const int pk = tid & 127, tq = tid >> 7;
    v4u rf[4], rv[4];
#define H1_LOAD(it_) do { const int bh_ = (it_) >> 5, j_ = (it_) & 31; const size_t rb_ = (size_t)((bh_ >> 3) * SEQ + j_ * 128) * 1024 + (bh_ & 7) * 128; \
        _Pragma("unroll") for (int i_ = 0; i_ < 4; ++i_) { rf[i_] = *(const v4u*)(P.FB + rb_ + (size_t)((tid >> 4) + 32 * i_) * 1024 + (tid & 15) * 8); rv[i_] = *(const v4u*)(P.VB + rb_ + (size_t)((tid & 31) + 32 * i_) * 1024 + (tid >> 5) * 8); } } while (0)
    if (first < last) H1_LOAD(first);
    for (int item = first; item < last; item += step) {
        const int h = (item >> 5) & 7, col0 = h * 128;
        const float oml = 1.f - 1.f / (1.f + fexp(P.hlb[1024 + col0 + pk] - P.hlb[col0 + pk]));
#pragma unroll
        for (int i = 0; i < 4; ++i) { *(LAS v4u*)(FRB + ((tid >> 4) + 32 * i) * 128 + (tid & 15) * 8) = rf[i];
#pragma unroll
            for (int e = 0; e < 4; ++e) { VT2[((tid >> 5) * 8 + 2 * e) * 136 + (tid & 31) + 32 * i] = (bf16)(rv[i][e] & 0xffffu); VT2[((tid >> 5) * 8 + 2 * e + 1) * 136 + (tid & 31) + 32 * i] = (bf16)(rv[i][e] >> 16); } }
        if (item + step < last) H1_LOAD(item + step);
        LDS_BARRIER();
        float kk[32], lf[32]; float tot = 0.f;
#pragma unroll
        for (int e = 0; e < 32; ++e) { const float fr = bf2f(FRB[(32 * tq + e) * 128 + pk]); kk[e] = oml * __builtin_amdgcn_rcpf(1.f + fexp(fr)); lf[e] = __logf(1.f - kk[e]); tot += lf[e]; }
        TOT2[tq * 128 + pk] = tot;
        LDS_BARRIER();
        { const float t0 = TOT2[pk], t1 = TOT2[128 + pk], t2 = TOT2[256 + pk], t3 = TOT2[384 + pk];
          float sfx = (tq < 1 ? t1 : 0.f) + (tq < 2 ? t2 : 0.f) + (tq < 3 ? t3 : 0.f);
          if (tq == 0) P.DEC[(size_t)item * 128 + pk] = fexp((t0 + t1) + (t2 + t3));
#pragma unroll
          for (int i = 3; i >= 0; --i) { float kt[8];
#pragma unroll
              for (int e = 7; e >= 0; --e) { kt[e] = kk[8 * i + e] * fexp(sfx); sfx += lf[8 * i + e]; }
              v4u o; o.x = pk2(kt[0], kt[1]); o.y = pk2(kt[2], kt[3]); o.z = pk2(kt[4], kt[5]); o.w = pk2(kt[6], kt[7]);
              *(LAS v4u*)(KT2 + pk * 136 + 32 * tq + 8 * i) = o; } }
        LDS_BARRIER();
        f32x4 accS[8];
#pragma unroll
        for (int vb = 0; vb < 8; ++vb) accS[vb] = (f32x4){0.f, 0.f, 0.f, 0.f};
#pragma unroll
        for (int tb = 0; tb < 4; ++tb) { const bf16x8 a = *(const LAS bf16x8*)(KT2 + (16 * w + li) * 136 + 32 * tb + 8 * lg);
#pragma unroll
            for (int vb = 0; vb < 8; ++vb) { const bf16x8 bb = *(const LAS bf16x8*)(VT2 + (16 * vb + li) * 136 + 32 * tb + 8 * lg); accS[vb] = __builtin_amdgcn_mfma_f32_16x16x32_bf16(a, bb, accS[vb], 0, 0, 0); } }
        float* stp = P.ST + (size_t)item * 16384 + (size_t)(16 * w + 4 * lg) * 128 + li;
#pragma unroll
        for (int vb = 0; vb < 8; ++vb)
#pragma unroll
            for (int jj = 0; jj < 4; ++jj) stp[jj * 128 + 16 * vb] = accS[vb][jj];
        LDS_BARRIER();
    }
#undef H1_LOAD
}

constexpr int H3_BA = 0, H3_BB = 34816, H3_VT = 69632, H3_SVT = 104448, H3_TOT = 139264, H3_EL = 141312 - 512;
__device__ __forceinline__ void hgrn_pass3(LAS unsigned char* lds, const HgPtrs& P, int first, int step, int last, int tid) {
    LAS bf16* BA = (LAS bf16*)(lds + H3_BA); LAS bf16* BB = (LAS bf16*)(lds + H3_BB); LAS bf16* VT = (LAS bf16*)(lds + H3_VT); LAS bf16* SVT = (LAS bf16*)(lds + H3_SVT);
    LAS float* TOT = (LAS float*)(lds + H3_TOT); LAS float* EL = (LAS float*)(lds + H3_EL);
    const int lane = tid & 63, w = __builtin_amdgcn_readfirstlane(tid >> 6), li = lane & 15, lg = lane >> 4;
    const int pk = tid & 127, tq = tid >> 7;
    v4u rf[4], rq[4], rv[4], rg[4];
#define H3_LOAD(it_) do { const int bh_ = (it_) >> 5, j_ = (it_) & 31; const size_t rb_ = (size_t)((bh_ >> 3) * SEQ + j_ * 128) * 1024 + (bh_ & 7) * 128; \
        _Pragma("unroll") for (int i_ = 0; i_ < 4; ++i_) { const size_t o_ = rb_ + (size_t)((tid >> 4) + 32 * i_) * 1024 + (tid & 15) * 8; rf[i_] = *(const v4u*)(P.FB + o_); rq[i_] = *(const v4u*)(P.QB + o_); \
            rv[i_] = *(const v4u*)(P.VB + rb_ + (size_t)((tid & 31) + 32 * i_) * 1024 + (tid >> 5) * 8); } } while (0)
    for (int item = first; item < last; item += step) {
        H3_LOAD(item);
        const int bh = item >> 5, j = item & 31, h = bh & 7, col0 = h * 128; const size_t rb = (size_t)((bh >> 3) * SEQ + j * 128) * 1024 + col0;
        const float oml = 1.f - 1.f / (1.f + fexp(P.hlb[1024 + col0 + pk] - P.hlb[col0 + pk]));
#pragma unroll
        for (int i = 0; i < 4; ++i) { rg[i] = *(const v4u*)(P.GB + rb + (size_t)((tid >> 4) + 32 * i) * 1024 + (tid & 15) * 8);
            *(LAS v4u*)(BA + ((tid >> 4) + 32 * i) * 136 + (tid & 15) * 8) = rf[i]; *(LAS v4u*)(BB + ((tid >> 4) + 32 * i) * 136 + (tid & 15) * 8) = rq[i];
#pragma unroll
            for (int e = 0; e < 4; ++e) { VT[((tid >> 5) * 8 + 2 * e) * 136 + (tid & 31) + 32 * i] = (bf16)(rv[i][e] & 0xffffu); VT[((tid >> 5) * 8 + 2 * e + 1) * 136 + (tid & 31) + 32 * i] = (bf16)(rv[i][e] >> 16); } }
        LDS_BARRIER();
        float kk[32], lf[32]; float tot = 0.f;
#pragma unroll
        for (int e = 0; e < 32; ++e) { const float fr = bf2f(BA[(32 * tq + e) * 136 + pk]); kk[e] = oml * __builtin_amdgcn_rcpf(1.f + fexp(fr)); lf[e] = __logf(1.f - kk[e]); tot += lf[e]; }
        if (tq < 3) TOT[tq * 128 + pk] = tot;
        LDS_BARRIER();
        { const float t0 = TOT[pk], t1 = TOT[128 + pk], t2 = TOT[256 + pk]; const float r = t0 + t1;
          float cum = (tq > 0 ? t0 : 0.f) + (tq > 1 ? t1 : 0.f) + (tq > 2 ? t2 : 0.f);
          if (tq == 0) EL[pk] = fexp(r);
#pragma unroll
          for (int e = 0; e < 32; ++e) { const int t = 32 * tq + e; cum += lf[e]; const float qr = bf2f(BB[t * 136 + pk]);
              BB[t * 136 + pk] = (bf16)(pk2(qr * pg8::sigm(qr) * fexp(cum - r), 0.f) & 0xffffu); BA[t * 136 + pk] = (bf16)(pk2(kk[e] * fexp(r - cum), 0.f) & 0xffffu); } }
        LDS_BARRIER();
        { const f32x4 el = *(const LAS f32x4*)(EL + 16 * w + 4 * lg);
          f32x4 S[8]; const float* stp = P.ST + (size_t)item * 16384 + (size_t)(16 * w + 4 * lg) * 128 + li;
#pragma unroll
          for (int vb = 0; vb < 8; ++vb)
#pragma unroll
              for (int jj = 0; jj < 4; ++jj) S[vb][jj] = stp[jj * 128 + 16 * vb];
#pragma unroll
          for (int vb = 0; vb < 8; ++vb) { const f32x4 sv = S[vb] * el; v2u o; o.x = pk2(sv[0], sv[1]); o.y = pk2(sv[2], sv[3]); *(LAS v2u*)(SVT + (16 * vb + li) * 136 + 16 * w + 4 * lg) = o; } }
        LDS_BARRIER();
        bf16x8 qa[4];
#pragma unroll
        for (int kb = 0; kb < 4; ++kb) qa[kb] = *(const LAS bf16x8*)(BB + (16 * w + li) * 136 + 32 * kb + 8 * lg);
        f32x4 acc[8], sc[8];
#pragma unroll
        for (int vb = 0; vb < 8; ++vb) { acc[vb] = (f32x4){0.f, 0.f, 0.f, 0.f}; sc[vb] = (f32x4){0.f, 0.f, 0.f, 0.f};
#pragma unroll
            for (int kb = 0; kb < 4; ++kb) acc[vb] = __builtin_amdgcn_mfma_f32_16x16x32_bf16(qa[kb], *(const LAS bf16x8*)(SVT + (16 * vb + li) * 136 + 32 * kb + 8 * lg), acc[vb], 0, 0, 0); }
#pragma unroll
        for (int sb = 0; sb < 8; ++sb) if (sb <= w) {
#pragma unroll
            for (int kb = 0; kb < 4; ++kb) sc[sb] = __builtin_amdgcn_mfma_f32_16x16x32_bf16(qa[kb], *(const LAS bf16x8*)(BA + (16 * sb + li) * 136 + 32 * kb + 8 * lg), sc[sb], 0, 0, 0); }
        LDS_BARRIER();
#pragma unroll
        for (int sb = 0; sb < 8; ++sb) if (sb <= (w | 1)) {
#pragma unroll
            for (int jj = 0; jj < 4; ++jj) { const int t = 16 * w + 4 * lg + jj, s = 16 * sb + li; BA[t * 136 + s] = (bf16)(pk2((sb <= w && s <= t) ? sc[sb][jj] : 0.f, 0.f) & 0xffffu); } }
#pragma unroll
        for (int i = 0; i < 4; ++i) *(LAS v4u*)(BB + ((tid >> 4) + 32 * i) * 136 + (tid & 15) * 8) = rg[i];
        LDS_BARRIER();
#pragma unroll
        for (int ks = 0; ks < 4; ++ks) if (ks <= (w >> 1)) { const bf16x8 pa = *(const LAS bf16x8*)(BA + (16 * w + li) * 136 + 32 * ks + 8 * lg);
#pragma unroll
            for (int vb = 0; vb < 8; ++vb) acc[vb] = __builtin_amdgcn_mfma_f32_16x16x32_bf16(pa, *(const LAS bf16x8*)(VT + (16 * vb + li) * 136 + 32 * ks + 8 * lg), acc[vb], 0, 0, 0); }
        f32x4 ss = (f32x4){0.f, 0.f, 0.f, 0.f};
#pragma unroll
        for (int vb = 0; vb < 8; ++vb) ss += acc[vb] * acc[vb];
#pragma unroll
        for (int jj = 0; jj < 4; ++jj) { float v = ss[jj]; v += __shfl_xor(v, 1); v += __shfl_xor(v, 2); v += __shfl_xor(v, 4); v += __shfl_xor(v, 8); ss[jj] = __builtin_amdgcn_rsqf(v * (1.f / 128.f) + RMS_EPS); }
        asm volatile("s_waitcnt lgkmcnt(0)" ::: "memory");
#pragma unroll
        for (int vb = 0; vb < 8; ++vb) { const float nwv = P.nw[16 * vb + li];
#pragma unroll
            for (int jj = 0; jj < 4; ++jj) { const int t = 16 * w + 4 * lg + jj; const float gr = bf2f(BB[t * 136 + 16 * vb + li]);
                BA[t * 136 + 16 * vb + li] = (bf16)(pk2(acc[vb][jj] * ss[jj] * nwv * gr * pg8::sigm(gr), 0.f) & 0xffffu); } }
        asm volatile("s_waitcnt lgkmcnt(0)" ::: "memory");
#pragma unroll
        for (int i = 0; i < 4; ++i) { const int t = 16 * w + (lane >> 4) + 4 * i, c8 = (lane & 15) * 8; *(v4u*)(P.YB + rb + (size_t)t * 1024 + c8) = *(const LAS v4u*)(BA + t * 136 + c8); }
        LDS_BARRIER();
    }
#undef H3_LOAD
}
__device__ __forceinline__ void hgrn_scan(float* ST, const float* DEC, int gt, int ngt) {
    for (int gi = gt; gi < 32 * 4096; gi += ngt) {
        const int bh = gi >> 12, i4 = gi & 4095, k = i4 >> 5;
        f32x4 S = (f32x4){0.f, 0.f, 0.f, 0.f}; f32x4 L[32]; float dd[32];
#pragma unroll
        for (int j = 0; j < 32; ++j) { L[j] = *((const f32x4*)(ST + (size_t)(bh * 32 + j) * 16384) + i4); dd[j] = DEC[(size_t)(bh * 32 + j) * 128 + k]; }
#pragma unroll
        for (int j = 0; j < 32; ++j) { *((f32x4*)(ST + (size_t)(bh * 32 + j) * 16384) + i4) = S; S = S * dd[j] + L[j]; }
    }
}

struct Args { const float* in[17]; float* out; unsigned char* ws; int ph_lo, ph_hi; };
static_assert(sizeof(Args) == 17 * 8 + 8 + 8 + 8, "Args has no padding");
constexpr int N_PHASES = 18;

__global__ void __launch_bounds__(NTHREADS, 2) mk_fwd(Args args) {
    extern __shared__ __attribute__((aligned(16))) unsigned char lds_raw[];
    LAS unsigned char* lds = (LAS unsigned char*)lds_raw;
    cg::grid_group grid = cg::this_grid();
    if (args.ph_lo < 0) grid.sync();
    const int wave = __builtin_amdgcn_readfirstlane(threadIdx.x >> 6);
    const int G = gridDim.x;
    int bx = blockIdx.x;
#ifndef MK_NO_VB
    { unsigned* rk = (unsigned*)args.ws + 4096; volatile LAS unsigned* M0 = (volatile LAS unsigned*)((LAS unsigned char*)lds_raw + MISC_OFF);
      if (threadIdx.x == 0) { const unsigned x = xb_xcc_id(); const unsigned r = xb_add(&rk[64 * x], 1u); unsigned sum, below, bad, sp = 0u;
          for (;;) { sum = 0u; below = 0u; bad = 0u;
#pragma unroll
              for (unsigned j = 0; j < 16; ++j) { const unsigned c = xb_ld(&rk[64 * j]); sum += c; bad |= (c != 0u && c != (unsigned)G / 8u) ? 1u : 0u; below += (c != 0u && j < x) ? 1u : 0u; }
              if (sum == (unsigned)G) break;
              __builtin_amdgcn_s_sleep(2); if (++sp > (1u << 20)) { bad = 1u; break; } }
          M0[100] = (bad || (G & 7)) ? (unsigned)blockIdx.x : (below + 8u * r); }
      __syncthreads(); bx = __builtin_amdgcn_readfirstlane((int)M0[100]); __syncthreads(); }
#endif
    const int gw = bx * NWAVES + wave, ngw = G * NWAVES;
    const bool xl = (G == 256); const int xr0 = 2048 * (bx & 7) + 64 * (bx >> 3);
    const int hg_first = xl ? ((((bx & 7) >> 1) * 8 + 4 * ((bx >> 3) & 1)) * 32 + 16 * (bx & 1) + (bx >> 4)) : bx, hg_step = xl ? 32 : G, hg_last = xl ? hg_first + 128 : 1024;
    const int ngt = G * NTHREADS;
#define FRESH() int tid = threadIdx.x; asm volatile("" : "+v"(tid)); const int lane = tid & 63; const int gt = bx * NTHREADS + tid; (void)lane; (void)gt
    unsigned char* ws = args.ws;
    const float* x = args.in[0]; const float* pin = args.in[1]; const float* ln_g = args.in[2]; const float* ln_b = args.in[3];
    float* out = args.out;
    bf16* XN = (bf16*)(ws + WS_XN); bf16* HB = (bf16*)(ws + WS_H); bf16* Z = (bf16*)(ws + WS_Z); bf16* PB = (bf16*)(ws + WS_PB);
    bf16* W1IN = (bf16*)(ws + WS_W1IN); bf16* W1OUT = (bf16*)(ws + WS_W1OUT); bf16* WMIX = (bf16*)(ws + WS_WMIX); bf16* WA = (bf16*)(ws + WS_WA); bf16* WB = (bf16*)(ws + WS_WB);
    bf16* WMO = (bf16*)(ws + WS_WMO); bf16* WPG = (bf16*)(ws + WS_WPG); bf16* WPP = (bf16*)(ws + WS_WPP); bf16* W2IN = (bf16*)(ws + WS_W2IN); bf16* W2OUT = (bf16*)(ws + WS_W2OUT);
    float* ST = (float*)(ws + WS_XN); pg8::f32x2* MUR = (pg8::f32x2*)(ws + 65536);
#ifdef MK_MGALT
    bf16* MG = (bf16*)(ws + WS_BIG + 128 * HMiB);
#else
    bf16* MG = (bf16*)(ws + WS_XN);
#endif
    float* DEC = (float*)(ws + WS_DEC); bf16* T1 = (bf16*)(ws + WS_T1); bf16* PP = (bf16*)(ws + WS_PP);
    bf16* SGC = Z + 6 * ZSZ; bf16* SGH = Z + 8 * ZSZ;
    const int lo = args.ph_lo, hi = args.ph_hi;
    volatile LAS unsigned* MISC = (volatile LAS unsigned*)(lds + MISC_OFF);
    if (threadIdx.x < 64) MISC[threadIdx.x] = 0u;
    __syncthreads();
    const XcdBarrier bar = xcd_barrier_post((unsigned*)ws, MISC + 8);
#ifndef MK_DBL
#define MK_DBL 0
#endif
#ifndef MK_ALIGN
#define MK_ALIGN true
#endif
#ifndef MK_DSEAM
#define MK_DSEAM 0
#endif
#ifndef MK_WG_K5504
#define MK_WG_K5504 MK_WGM
#endif
#ifndef MK_WG_N2048
#define MK_WG_N2048 MK_WGM
#endif
#ifndef MK_SP2
#define MK_SP2 true
#endif
#define NREP(k) ((((MK_DBL) >> (k)) & 1) ? 2 : 1)
#define IN(k) (lo <= (k) && (k) < hi)
#define SEAM(k) do { if (IN(k) && IN((k) + 1)) { { xcd_barrier(bar); if (MK_DSEAM) xcd_barrier(bar); } } } while (0)
    LAS float* scr = (LAS float*)(lds + wave * 16384);

    if (IN(0)) for (int rep = 0; rep < NREP(0); ++rep) { FRESH();
        constexpr int I0 = (D / 64) * (2 * FF / 32), I1 = (FF / 64) * (D / 32), I2 = (D / 64) * (NMIX / 32), I3 = (CW / 64) * (D / 32), I4 = (D / 64) * (D / 32), I5 = (PLE / 64) * (D / 32);
        constexpr int NIT = I0 + I1 + I2 + 2 * I3 + 2 * I4 + I5;
#define P0_JOB(J, it_) do { int r = (it_); \
            if (r < I0) { J = tjob(args.in[4], D, 2 * FF, W1IN, 1, r); break; } r -= I0; \
            if (r < I1) { J = tjob(args.in[5], FF, D, W1OUT, 0, r); break; } r -= I1; \
            if (r < I2) { J = tjob(args.in[6], D, NMIX, WMIX, 2, r); break; } r -= I2; \
            if (r < I3) { J = tjob(args.in[10], CW, D, WA, 0, r); break; } r -= I3; \
            if (r < I3) { J = tjob(args.in[11], CW, D, WB, 0, r); break; } r -= I3; \
            if (r < I4) { J = tjob(args.in[12], D, D, WMO, 0, r); break; } r -= I4; \
            if (r < I4) { J = tjob(args.in[15], D, D, WPG, 0, r); break; } r -= I4; \
            J = tjob(args.in[16], PLE, D, WPP, 0, r); } while (0)
        { TJob ja, jb; float ta[32], tb[32];
          int it = gw; if (it < NIT) { P0_JOB(ja, it); TJ_LOAD(ta, ja, lane); }
          for (; it < NIT; it += 2 * ngw) {
              const bool hb = it + ngw < NIT; if (hb) { P0_JOB(jb, it + ngw); TJ_LOAD(tb, jb, lane); }
              tjob_finish(ja, ta, scr, lane);
              const bool ha = it + 2 * ngw < NIT; if (ha) { P0_JOB(ja, it + 2 * ngw); TJ_LOAD(ta, ja, lane); }
              if (hb) tjob_finish(jb, tb, scr, lane); } }
#undef P0_JOB
        cvt_copy(x, XN, (size_t)M * D, gt, ngt);
        cvt_copy(pin, PB, (size_t)M * PLE, gt, ngt);
        __syncthreads();
    }
    SEAM(0);
    if (IN(1)) for (int rep = 0; rep < NREP(1); ++rep) { pg8::Gemm g{XN, W1IN, M, 2 * FF, D}; pg8::StaticOrder S; S.init(M, 2 * FF, G, bx); pg8::EpiSwiGLU E{HB, FF};
        pg8::gemm_phase<pg8::EpiSwiGLU, pg8::StaticOrder, MK_ALIGN, MK_SP2>(lds, g, S, E); }
    SEAM(1);
    if (IN(2)) for (int rep = 0; rep < NREP(2); ++rep) { pg8::Gemm g{HB, W1OUT, M, D, FF}; pg8::StaticOrder S; S.init(M, D, G, bx, MK_WG_K5504); pg8::EpiResid E{x, out, ALPHA, 0.5f};
        pg8::gemm_phase<pg8::EpiResid, pg8::StaticOrder, MK_ALIGN, MK_SP2>(lds, g, S, E); }
    SEAM(2);
    if (IN(3)) { FRESH(); ln_pass(out, XN, MUR, ln_g, ln_b, xl ? xr0 + 8 * wave : gw, xl ? 1 : ngw, lane, xl ? xr0 + 8 * wave + 8 : M); }
    SEAM(3);
    if (IN(4)) for (int rep = 0; rep < NREP(4); ++rep) { pg8::Gemm g{XN, WMIX, M, NMIX, D}; pg8::StaticOrder S; S.init(M, NMIX, G, bx); pg8::EpiMix E{Z, ZSZ};
        pg8::gemm_phase<pg8::EpiMix, pg8::StaticOrder, MK_ALIGN, MK_SP2>(lds, g, S, E); }
    SEAM(4);
    HgPtrs HP{Z + 2 * ZSZ, Z + 3 * ZSZ, Z + 4 * ZSZ, Z + 5 * ZSZ, Z + ZSZ, ST, DEC, args.in[8], args.in[9]};
    if (IN(5)) { FRESH(); { const int cg0 = ((xr0 >> 4) + (tid >> 7)) * 128 + (tid & 127); conv_pass(Z, Z + ZSZ, args.in[7], xl ? cg0 : gt, xl ? 1 : ngt, xl ? cg0 + 1 : (M / 16) * 128); }
#ifndef MK_SKIPHG
        for (int rep = 0; rep < NREP(5); ++rep) hgrn_pass1(lds, HP, hg_first, hg_step, hg_last, tid);
#endif
    }
    SEAM(5);
#ifndef MK_SKIPHG
    if (IN(6)) { FRESH(); hgrn_scan(ST, DEC, gt, ngt); }
#endif
    SEAM(6);
#ifndef MK_SKIPHG
    if (IN(7)) { FRESH(); for (int rep = 0; rep < NREP(7); ++rep) hgrn_pass3(lds, HP, hg_first, hg_step, hg_last, tid); }
#else
#ifdef MK_YBSUM
    if (IN(7)) { FRESH(); for (size_t i = (size_t)gt * 8; i < ZSZ; i += (size_t)ngt * 8) { const v4u a = *(const v4u*)(Z + 2 * ZSZ + i), b = *(const v4u*)(Z + 3 * ZSZ + i), c = *(const v4u*)(Z + 4 * ZSZ + i), d = *(const v4u*)(Z + 5 * ZSZ + i); v4u o;
#pragma unroll
        for (int e = 0; e < 4; ++e) o[e] = pk2(0.25f * (pg8::bf_lo(a[e]) + pg8::bf_lo(b[e]) + pg8::bf_lo(c[e]) + pg8::bf_lo(d[e])), 0.25f * (pg8::bf_hi(a[e]) + pg8::bf_hi(b[e]) + pg8::bf_hi(c[e]) + pg8::bf_hi(d[e])));
        *(v4u*)(Z + ZSZ + i) = o; } }
#else
    if (IN(7)) { FRESH(); for (size_t i = (size_t)gt * 8; i < ZSZ; i += (size_t)ngt * 8) *(v4u*)(Z + ZSZ + i) = (v4u){0u, 0u, 0u, 0u}; }
#endif
#endif
    SEAM(7);
#ifndef MK_SKIPBR
    if (IN(8)) { pg8::Gemm g{Z, WA, M, D, CW}; pg8::StaticOrder S; S.init(M, D, G, bx, MK_WG_N2048); pg8::EpiBr1 E{SGC, T1};
        pg8::gemm_phase<pg8::EpiBr1, pg8::StaticOrder, MK_ALIGN, MK_SP2>(lds, g, S, E); }
#ifdef MK_SEAM8
    SEAM(8);
#endif
    if (IN(9)) { pg8::Gemm g{Z + ZSZ, WB, M, D, CW}; pg8::StaticOrder S; S.init(M, D, G, bx, MK_WG_N2048); pg8::EpiBr2 E{SGH, T1, MG};
        pg8::gemm_phase<pg8::EpiBr2, pg8::StaticOrder, MK_ALIGN, MK_SP2>(lds, g, S, E); }
#else
#ifdef MK_GATESUM
    if (IN(9)) { FRESH(); for (size_t i = (size_t)gt * 8; i < (size_t)M * D; i += (size_t)ngt * 8) { const size_t row = i >> 11, c = i & 2047; const v4u a = *(const v4u*)(Z + row * 1024 + (c & 1023)), g1 = *(const v4u*)(SGC + i), g2 = *(const v4u*)(SGH + i); v4u o;
#pragma unroll
        for (int e = 0; e < 4; ++e) o[e] = pk2(pg8::bf_lo(a[e]) * pg8::bf_lo(g1[e]) + pg8::bf_lo(g2[e]), pg8::bf_hi(a[e]) * pg8::bf_hi(g1[e]) + pg8::bf_hi(g2[e]));
        *(v4u*)(MG + i) = o; } }
#else
    if (IN(9)) { FRESH(); for (size_t i = (size_t)gt * 8; i < (size_t)M * D; i += (size_t)ngt * 8) { const size_t row = i >> 11, c = i & 2047; *(v4u*)(MG + i) = *(const v4u*)(Z + (c >> 10) * ZSZ + row * 1024 + (c & 1023)); } }
#endif
#endif
    SEAM(9);
    if (IN(10)) { FRESH();
        constexpr int I0 = (D / 64) * (2 * FF / 32), I1 = (FF / 64) * (D / 32);
#ifndef MK_NOCONV10
#define P10_JOB(J, it_) do { if ((it_) < I0) J = tjob(args.in[13], D, 2 * FF, W2IN, 1, (it_)); else J = tjob(args.in[14], FF, D, W2OUT, 0, (it_) - I0); } while (0)
        { TJob ja, jb; float ta[32], tb[32]; constexpr int NIT2 = I0 + I1;
          int it = gw; if (it < NIT2) { P10_JOB(ja, it); TJ_LOAD(ta, ja, lane); }
          for (; it < NIT2; it += 2 * ngw) {
              const bool hb = it + ngw < NIT2; if (hb) { P10_JOB(jb, it + ngw); TJ_LOAD(tb, jb, lane); }
              tjob_finish(ja, ta, scr, lane);
              const bool ha = it + 2 * ngw < NIT2; if (ha) { P10_JOB(ja, it + 2 * ngw); TJ_LOAD(ta, ja, lane); }
              if (hb) tjob_finish(jb, tb, scr, lane); } }
#undef P10_JOB
#endif
        __syncthreads();
        pg8::Gemm g{MG, WMO, M, D, D}; pg8::StaticOrder S; S.init(M, D, G, bx, MK_WG_N2048); pg8::EpiResidLN E{out, MUR, ln_g, ln_b, ALPHA, 1.0f};
        pg8::gemm_phase<pg8::EpiResidLN, pg8::StaticOrder, MK_ALIGN, MK_SP2>(lds, g, S, E); }
    SEAM(10);
    if (IN(11)) { FRESH(); ln_pass(out, XN, MUR, ln_g + D, ln_b + D, xl ? xr0 + 8 * wave : gw, xl ? 1 : ngw, lane, xl ? xr0 + 8 * wave + 8 : M); }
    SEAM(11);
    if (IN(12)) { pg8::Gemm g{XN, W2IN, M, 2 * FF, D}; pg8::StaticOrder S; S.init(M, 2 * FF, G, bx); pg8::EpiSwiGLU E{HB, FF};
        pg8::gemm_phase<pg8::EpiSwiGLU, pg8::StaticOrder, MK_ALIGN, MK_SP2>(lds, g, S, E); }
    SEAM(12);
    if (IN(13)) { pg8::Gemm g{HB, W2OUT, M, D, FF}; pg8::StaticOrder S; S.init(M, D, G, bx, MK_WG_K5504); pg8::EpiResidLN E{out, MUR, ln_g + D, ln_b + D, ALPHA, 0.5f};
        pg8::gemm_phase<pg8::EpiResidLN, pg8::StaticOrder, MK_ALIGN, MK_SP2>(lds, g, S, E); }
    SEAM(13);
    if (IN(14)) { FRESH(); ln_pass(out, XN, MUR, ln_g + 2 * D, ln_b + 2 * D, xl ? xr0 + 8 * wave : gw, xl ? 1 : ngw, lane, xl ? xr0 + 8 * wave + 8 : M); }
    SEAM(14);
    if (IN(15)) { int kple = PLE; asm volatile("" : "+s"(kple));
        pg8::Gemm g{PB, WPP, M, D, kple}; pg8::StaticOrder S; S.init(M, D, G, bx, MK_WG_N2048); pg8::EpiF32P E{PP};
        pg8::gemm_phase<pg8::EpiF32P, pg8::StaticOrder, MK_ALIGN, MK_SP2>(lds, g, S, E); }
    if (IN(16)) { pg8::Gemm g{XN, WPG, M, D, D}; pg8::StaticOrder S; S.init(M, D, G, bx, MK_WG_N2048); pg8::EpiPleLN E{PP, out, MUR, ln_g + 2 * D, ln_b + 2 * D, ALPHA};
        pg8::gemm_phase<pg8::EpiPleLN, pg8::StaticOrder, MK_ALIGN, MK_SP2>(lds, g, S, E); }
    SEAM(16);
    if (IN(17)) { FRESH(); ln_pass(out, (bf16*)nullptr, (pg8::f32x2*)nullptr, ln_g + 3 * D, ln_b + 3 * D, xl ? xr0 + 8 * wave : gw, xl ? 1 : ngw, lane, xl ? xr0 + 8 * wave + 8 : M); }
#undef IN
#undef SEAM
#undef FRESH
}

extern "C" void kernel_launch(void* const* d_in, const int* in_sizes, int n_in, void* d_out, int out_size, void* d_ws, size_t ws_size, hipStream_t stream) {
    static int grid = 0;
    if (grid == 0) {
        if (n_in != 17 || in_sizes[0] != M * D || out_size != M * D || ws_size < WS_END) { fprintf(stderr, "kernel_launch: unexpected shapes (n_in %d, in0 %d, out %d, ws %zu < %zu)\n", n_in, n_in > 0 ? in_sizes[0] : -1, out_size, ws_size, (size_t)WS_END); grid = -1; return; }
        int dev = 0, cus = 0, per_cu = 0;
        (void)hipGetDevice(&dev); (void)hipDeviceGetAttribute(&cus, hipDeviceAttributeMultiprocessorCount, dev);
        if (hipFuncSetAttribute((const void*)mk_fwd, hipFuncAttributeMaxDynamicSharedMemorySize, LDS_BYTES) != hipSuccess) { fprintf(stderr, "kernel_launch: hipFuncSetAttribute failed\n"); grid = -1; return; }
        if (hipOccupancyMaxActiveBlocksPerMultiprocessor(&per_cu, (const void*)mk_fwd, NTHREADS, LDS_BYTES) != hipSuccess || per_cu < 1) { fprintf(stderr, "kernel_launch: occupancy query says %d\n", per_cu); per_cu = 1; }
        (void)hipGetLastError();
        grid = cus * per_cu;
    }
    if (grid < 0) return;
#ifdef MK_POISON
    (void)hipMemsetAsync(d_ws, 0xFF, WS_END, stream); (void)hipMemsetAsync(d_out, 0xFF, (size_t)M * D * 4, stream);
#endif
    if (hipMemsetAsync(d_ws, 0, 32768, stream) != hipSuccess) { fprintf(stderr, "kernel_launch: memset of the barrier words failed\n"); return; }
    Args a{};
    for (int i = 0; i < 17; ++i) a.in[i] = (const float*)d_in[i];
    a.out = (float*)d_out; a.ws = (unsigned char*)d_ws;
    void* kargs[] = {&a};
#if MK_N_LAUNCHES == 1
#ifdef MK_STOP
    a.ph_lo = 0; a.ph_hi = MK_STOP;
#else
    a.ph_lo = 0; a.ph_hi = N_PHASES;
#endif
    hipError_t e = hipLaunchCooperativeKernel((const void*)mk_fwd, dim3(grid), dim3(NTHREADS), kargs, LDS_BYTES, stream);
    if (e != hipSuccess) fprintf(stderr, "kernel_launch: cooperative launch failed: %s (grid %d)\n", hipGetErrorString(e), grid);
#else
    const int cuts[] = {0, 1, 2, 3, 4, 5, 6, 7, 8, 10, 11, 12, 13, 14, 15, 17, 18};
    for (int li = 0; li + 1 < (int)(sizeof(cuts) / sizeof(cuts[0])); ++li) {
        a.ph_lo = cuts[li]; a.ph_hi = cuts[li + 1];
        hipError_t e = hipLaunchCooperativeKernel((const void*)mk_fwd, dim3(grid), dim3(NTHREADS), kargs, LDS_BYTES, stream);
        if (e != hipSuccess) { fprintf(stderr, "kernel_launch: launch %d failed: %s (grid %d)\n", li, hipGetErrorString(e), grid); break; }
    }
#endif
}
```
